# Optimizing an MI355X kernel written in HIP

```python
import math
import jax, jax.numpy as jnp
from jax import lax
import numpy as np

D_MODEL = 1024
BATCH = 16
SEQ = 2048
DEPTH = 2

HEAD_DIM = 64
N_DIFF = 4
DIFF_V = 2 * HEAD_DIM
N_FOX = 8
N_SB = 8
N_BRANCH = 3
D_FF = 2816
Q_BLOCK = 128
EPS = 1e-6
SUBLN_EPS = 1e-5

A_QK = N_DIFF * 2 * HEAD_DIM
W_A = N_DIFF * DIFF_V
W_B = N_FOX * HEAD_DIM
W_C = N_SB * HEAD_DIM
IN_SIZES = (A_QK, A_QK, W_A, W_B, W_B, W_B, N_FOX, W_C, W_C, W_C, N_BRANCH * D_MODEL)
N_IN = 9 * 512 + N_FOX + N_BRANCH * D_MODEL

kernel_name = "hybrid_diff_fox_stickbreak_macaron"


def _rmsnorm(x, g, eps=EPS):
    x32 = x.astype(jnp.float32)
    y = x32 * lax.rsqrt(jnp.mean(x32 * x32, axis=-1, keepdims=True) + eps)
    return (y * g.astype(jnp.float32)).astype(x.dtype)


def _swiglu(x, w1, w3, w2):
    return (jax.nn.silu(x @ w1) * (x @ w3)) @ w2


def _alibi_slopes(n_heads):
    return jnp.asarray([2.0 ** (-8.0 * (h + 1) / n_heads) for h in range(n_heads)], jnp.float32)


def _sweep(block_fn, seq):
    out = lax.map(block_fn, jnp.arange(seq // Q_BLOCK))
    nb, b, h, qb, e = out.shape
    return out.transpose(1, 0, 3, 2, 4).reshape(b, nb * qb, h * e)


def _diff_attention(q, k, v, lq1, lk1, lq2, lk2, subln_g, lam_init):
    b, s = q.shape[:2]
    q = q.reshape(b, s, N_DIFF, 2, HEAD_DIM)
    k = k.reshape(b, s, N_DIFF, 2, HEAD_DIM)
    v = v.reshape(b, s, N_DIFF, DIFF_V)
    f32 = jnp.float32
    lam = (jnp.exp(jnp.sum(lq1.astype(f32) * lk1.astype(f32)))
           - jnp.exp(jnp.sum(lq2.astype(f32) * lk2.astype(f32))) + lam_init)
    slopes = _alibi_slopes(N_DIFF)[:, None, None, None]
    scale = 1.0 / math.sqrt(HEAD_DIM)
    key_pos = jnp.arange(s)

    def block(i):
        qb = lax.dynamic_slice_in_dim(q, i * Q_BLOCK, Q_BLOCK, axis=1)
        dist = (i * Q_BLOCK + jnp.arange(Q_BLOCK))[:, None] - key_pos[None, :]
        logits = (jnp.einsum('bqhcd,bkhcd->bhcqk', qb, k).astype(f32) * scale
                  - slopes * dist.astype(f32))
        logits = jnp.where(dist >= 0, logits, -jnp.inf)
        p = jax.nn.softmax(logits, axis=-1)
        attn = p[:, :, 0] - lam * p[:, :, 1]
        return jnp.einsum('bhqk,bkhe->bhqe', attn.astype(v.dtype), v)

    o = _sweep(block, s).reshape(b, s, N_DIFF, DIFF_V)
    o = _rmsnorm(o, subln_g, SUBLN_EPS) * (1.0 - lam_init)
    return o.reshape(b, s, W_A)


def _forgetting_attention(q, k, v, f_logit, f_bias):
    b, s = q.shape[:2]
    q = q.reshape(b, s, N_FOX, HEAD_DIM)
    k = k.reshape(b, s, N_FOX, HEAD_DIM)
    v = v.reshape(b, s, N_FOX, HEAD_DIM)
    f32 = jnp.float32
    log_f = jax.nn.log_sigmoid(f_logit.astype(f32) + f_bias.astype(f32))
    c = jnp.cumsum(log_f, axis=1).transpose(0, 2, 1)
    scale = 1.0 / math.sqrt(HEAD_DIM)
    key_pos = jnp.arange(s)

    def block(i):
        qb = lax.dynamic_slice_in_dim(q, i * Q_BLOCK, Q_BLOCK, axis=1)
        cq = lax.dynamic_slice_in_dim(c, i * Q_BLOCK, Q_BLOCK, axis=2)
        dist = (i * Q_BLOCK + jnp.arange(Q_BLOCK))[:, None] - key_pos[None, :]
        logits = (jnp.einsum('bqhd,bkhd->bhqk', qb, k).astype(f32) * scale
                  + cq[..., :, None] - c[..., None, :])
        logits = jnp.where(dist >= 0, logits, -jnp.inf)
        p = jax.nn.softmax(logits, axis=-1)
        return jnp.einsum('bhqk,bkhe->bhqe', p.astype(v.dtype), v)

    return _sweep(block, s)


def _stick_breaking_attention(q, k, v):
    b, s = q.shape[:2]
    q = q.reshape(b, s, N_SB, HEAD_DIM)
    k = k.reshape(b, s, N_SB, HEAD_DIM)
    v = v.reshape(b, s, N_SB, HEAD_DIM)
    f32 = jnp.float32
    scale = 1.0 / math.sqrt(HEAD_DIM)
    key_pos = jnp.arange(s)

    def block(i):
        qb = lax.dynamic_slice_in_dim(q, i * Q_BLOCK, Q_BLOCK, axis=1)
        dist = (i * Q_BLOCK + jnp.arange(Q_BLOCK))[:, None] - key_pos[None, :]
        strict = dist > 0
        z = jnp.einsum('bqhd,bkhd->bhqk', qb, k).astype(f32) * scale
        log_keep = jnp.where(strict, jax.nn.log_sigmoid(-z), 0.0)
        later = lax.cumsum(log_keep, axis=3, reverse=True) - log_keep
        w = jnp.where(strict, jnp.exp(jax.nn.log_sigmoid(z) + later), 0.0)
        return jnp.einsum('bhqk,bkhe->bhqe', w.astype(v.dtype), v)

    return _sweep(block, s)


def setup_inputs(seed: int = 0) -> dict:
    key = jax.random.key(seed)
    ks = jax.random.split(key, 24)
    f32 = jnp.float32

    def nrm(k, shape, fan_in):
        return jax.random.normal(k, shape, f32) * fan_in ** -0.5

    def gain(k, shape):
        return 1.0 + 0.05 * jax.random.normal(k, shape, f32)

    return {
        "x": jax.random.normal(ks[0], (BATCH, SEQ, D_MODEL), f32),
        "ffn1_norm": gain(ks[1], (DEPTH, D_MODEL)),
        "ffn1_w1": nrm(ks[2], (DEPTH, D_MODEL, D_FF), D_MODEL),
        "ffn1_w3": nrm(ks[3], (DEPTH, D_MODEL, D_FF), D_MODEL),
        "ffn1_w2": nrm(ks[4], (DEPTH, D_FF, D_MODEL), D_FF),
        "mix_norm": gain(ks[5], (DEPTH, D_MODEL)),
        "w_in": nrm(ks[6], (DEPTH, D_MODEL, N_IN), D_MODEL),
        "forget_bias": jax.random.uniform(ks[7], (DEPTH, N_FOX), f32, 1.0, 4.0),
        "diff_lq1": 0.1 * jax.random.normal(ks[8], (DEPTH, HEAD_DIM), f32),
        "diff_lk1": 0.1 * jax.random.normal(ks[9], (DEPTH, HEAD_DIM), f32),
        "diff_lq2": 0.1 * jax.random.normal(ks[10], (DEPTH, HEAD_DIM), f32),
        "diff_lk2": 0.1 * jax.random.normal(ks[11], (DEPTH, HEAD_DIM), f32),
        "diff_subln": gain(ks[12], (DEPTH, DIFF_V)),
        "proj_a": nrm(ks[13], (DEPTH, W_A, D_MODEL), W_A),
        "proj_b": nrm(ks[14], (DEPTH, W_B, D_MODEL), W_B),
        "proj_c": nrm(ks[15], (DEPTH, W_C, D_MODEL), W_C),
        "w_out": nrm(ks[16], (DEPTH, D_MODEL, D_MODEL), D_MODEL),
        "ffn2_norm": gain(ks[17], (DEPTH, D_MODEL)),
        "ffn2_w1": nrm(ks[18], (DEPTH, D_MODEL, D_FF), D_MODEL),
        "ffn2_w3": nrm(ks[19], (DEPTH, D_MODEL, D_FF), D_MODEL),
        "ffn2_w2": nrm(ks[20], (DEPTH, D_FF, D_MODEL), D_FF),
        "final_norm": gain(ks[21], (D_MODEL,)),
    }


def reference(x, ffn1_norm, ffn1_w1, ffn1_w3, ffn1_w2, mix_norm, w_in, forget_bias,
              diff_lq1, diff_lk1, diff_lq2, diff_lk2, diff_subln, proj_a, proj_b, proj_c,
              w_out, ffn2_norm, ffn2_w1, ffn2_w3, ffn2_w2, final_norm):
    split_idx = np.cumsum(IN_SIZES)[:-1].tolist()
    h = x
    b, s, _ = x.shape
    for l in range(DEPTH):
        h = h + 0.5 * _swiglu(_rmsnorm(h, ffn1_norm[l]), ffn1_w1[l], ffn1_w3[l], ffn1_w2[l])

        u = _rmsnorm(h, mix_norm[l])
        z = u @ w_in[l]
        (a_q, a_k, a_v, b_q, b_k, b_v, b_f, c_q, c_k, c_v, g) = jnp.split(z, split_idx, axis=-1)
        lam_init = 0.8 - 0.6 * math.exp(-0.3 * l)
        o_a = _diff_attention(a_q, a_k, a_v, diff_lq1[l], diff_lk1[l], diff_lq2[l],
                              diff_lk2[l], diff_subln[l], lam_init)
        o_b = _forgetting_attention(b_q, b_k, b_v, b_f, forget_bias[l])
        o_c = _stick_breaking_attention(c_q, c_k, c_v)
        gates = jax.nn.sigmoid(g.reshape(b, s, N_BRANCH, D_MODEL))
        m = (gates[:, :, 0] * (o_a @ proj_a[l])
             + gates[:, :, 1] * (o_b @ proj_b[l])
             + gates[:, :, 2] * (o_c @ proj_c[l]))
        h = h + m @ w_out[l]

        h = h + 0.5 * _swiglu(_rmsnorm(h, ffn2_norm[l]), ffn2_w1[l], ffn2_w3[l], ffn2_w2[l])
    return _rmsnorm(h, final_norm)
```

```cpp
#include <hip/hip_runtime.h>
#include <cstdio>
#include <cstdint>
namespace pg8 {
#define PG8_LAS __attribute__((address_space(3)))
typedef unsigned short bf16_t;
typedef short bf16x8 __attribute__((ext_vector_type(8)));
typedef float f32x4 __attribute__((ext_vector_type(4)));
typedef unsigned u32x4 __attribute__((ext_vector_type(4)));
constexpr int BM = 256, BK = 64, HALF = 128, HTB = HALF * BK * 2  , STAGE_BYTES = 8 * HTB, NXCD = 8, WGM = 8;

__host__ __device__ __forceinline__ int lds_byte(int r, int c) { const int st = (r >> 4) * 2 + (c >> 5), rr = r & 15, cc = c & 31, ob = rr * 64 + cc * 2; return st * 1024 + (ob ^ (((ob >> 9) & 1) << 5)); }
__host__ __device__ __forceinline__ void stage_rc(int b, int& R, int& C) { const int st = b / 1024, sb = b % 1024, swz = sb ^ (((sb >> 9) & 1) << 5); R = (st >> 1) * 16 + swz / 64; C = (st & 1) * 32 + (swz % 64) / 2; }
__host__ __device__ __forceinline__ int perm32(int rho) { const int n = rho >> 4, i = rho & 15; return 8 * (i >> 2) + 4 * n + (i & 3); }

struct Unit { int pm, pn; };
struct Gemm { const bf16_t* A; const bf16_t* Bt; int M, N, K; };

struct StaticOrder {
    int nM, nN, nwg, G, c;
    __host__ __device__ void init(int M, int N, int G_, int c_) { nM = M / BM; nN = N / BM; nwg = nM * nN; G = G_; c = c_; }
    __host__ __device__ bool next(int i, Unit& u) const {
        const long L = (long)i * G + c; if (L >= nwg) return false;
        int wgid = (int)L; { const int q = nwg / NXCD, r = nwg % NXCD, xcd = wgid % NXCD, off = wgid / NXCD; wgid = (xcd < r ? xcd * (q + 1) : r * (q + 1) + (xcd - r) * q) + off; }
        const int nig = WGM * nN, gid = wgid / nig, fm = gid * WGM, gsz = (nM - fm) < WGM ? (nM - fm) : WGM;
        u.pm = fm + ((wgid % nig) % gsz); u.pn = (wgid % nig) / gsz; return true;
    }
    __device__ __forceinline__ void a_ready(const Unit&) const {}
    __device__ __forceinline__ void done(const Unit&) const {}
};

typedef float pk_f32x2_t __attribute__((ext_vector_type(2))); typedef __bf16 pk_bf16x2_t __attribute__((ext_vector_type(2)));
__device__ __forceinline__ unsigned cvt_pk_bf16(float lo, float hi) { const pk_f32x2_t v = {lo, hi}; const pk_bf16x2_t b = __builtin_convertvector(v, pk_bf16x2_t); return __builtin_bit_cast(unsigned, b); }
typedef float f32x2 __attribute__((ext_vector_type(2)));
typedef unsigned u32x2 __attribute__((ext_vector_type(2)));
constexpr float LOG2E = 1.4426950408889634f;
typedef unsigned long long ssq_t;
constexpr float SSQ_SCALE = 16777216.0f;
#define PG8_GAS __attribute__((address_space(1)))
__device__ __forceinline__ float rstd_of(const ssq_t* ssq, int row) { return __builtin_amdgcn_rsqf((float)((const PG8_GAS ssq_t*)ssq)[row] * (1.0f / (SSQ_SCALE * 1024.0f)) + 1e-6f); }
__device__ __forceinline__ void rstd8(const ssq_t* ssq, int row0, float scale, float (&rsv)[2][4]) {
    ssq_t raw[2][4];
#pragma unroll
    for (int ai = 0; ai < 2; ++ai)
#pragma unroll
        for (int m = 0; m < 4; ++m) raw[ai][m] = ((const PG8_GAS ssq_t*)ssq)[row0 + ai * HALF + m * 16];
#pragma unroll
    for (int ai = 0; ai < 2; ++ai)
#pragma unroll
        for (int m = 0; m < 4; ++m) asm volatile("" : "+v"(raw[ai][m]));
#pragma unroll
    for (int ai = 0; ai < 2; ++ai)
#pragma unroll
        for (int m = 0; m < 4; ++m) rsv[ai][m] = __builtin_amdgcn_rsqf((float)raw[ai][m] * (1.0f / (SSQ_SCALE * 1024.0f)) + 1e-6f) * scale;
}
__device__ __forceinline__ float bf_lo(unsigned w) { return __uint_as_float(w << 16); }
__device__ __forceinline__ float bf_hi(unsigned w) { return __uint_as_float(w & 0xffff0000u); }

struct EpiSwiGLU {
    static constexpr bool PERM = true, AFTER_DRAIN = false;
    bf16_t* O; int ldc; const ssq_t* ssq;
    __device__ __forceinline__ void operator()(const f32x4 (&acc)[2][2][4][2], const Unit& u, int wr, int wc, int fr, int fq) const {
        const int row0 = u.pm * BM + wr * 64 + fr, col0 = u.pn * HALF + wc * 32 + 8 * fq;
        float rsv[2][4];
        rstd8(ssq, row0, 1.0f, rsv);
#pragma unroll
        for (int ai = 0; ai < 2; ++ai)
#pragma unroll
            for (int m = 0; m < 4; ++m) { const int row = row0 + ai * HALF + m * 16; const float rs = rsv[ai][m], rsn = rs * -LOG2E, rs2 = rs * rs;
                float h[8];
#pragma unroll
                for (int n = 0; n < 2; ++n)
#pragma unroll
                    for (int j = 0; j < 4; ++j) { const float a = acc[ai][0][m][n][j], bq = acc[ai][1][m][n][j];
                        h[4 * n + j] = ((a * bq) * rs2) * __builtin_amdgcn_rcpf(1.0f + __builtin_amdgcn_exp2f(a * rsn)); }
                u32x4 w; w.x = cvt_pk_bf16(h[0], h[1]); w.y = cvt_pk_bf16(h[2], h[3]); w.z = cvt_pk_bf16(h[4], h[5]); w.w = cvt_pk_bf16(h[6], h[7]);
                *(PG8_GAS u32x4*)(O + (size_t)row * ldc + col0) = w; }
    }
};
struct EpiRes {
    static constexpr bool PERM = true, AFTER_DRAIN = false;
    bf16_t* hb; ssq_t* ssq_next; float alpha;
    __device__ __forceinline__ void operator()(const f32x4 (&acc)[2][2][4][2], const Unit& u, int wr, int wc, int fr, int fq) const {
        const int row0 = u.pm * BM + wr * 64 + fr, col0 = u.pn * BM + wc * 32 + 8 * fq;
#pragma unroll
        for (int ai = 0; ai < 2; ++ai) {
            u32x4 pre[4][2];
#pragma unroll
            for (int m = 0; m < 4; ++m)
#pragma unroll
                for (int bj = 0; bj < 2; ++bj) pre[m][bj] = *(const PG8_GAS u32x4*)(hb + (size_t)(row0 + ai * HALF + m * 16) * 1024 + col0 + bj * HALF);
#pragma unroll
            for (int m = 0; m < 4; ++m) { const int row = row0 + ai * HALF + m * 16; float s = 0.f;
#pragma unroll
                for (int bj = 0; bj < 2; ++bj) { const u32x4 old = pre[m][bj]; const f32x4 a0 = acc[ai][bj][m][0], a1 = acc[ai][bj][m][1];
                    const float h0 = bf_lo(old.x) + alpha * a0[0], h1 = bf_hi(old.x) + alpha * a0[1], h2 = bf_lo(old.y) + alpha * a0[2], h3 = bf_hi(old.y) + alpha * a0[3];
                    const float h4 = bf_lo(old.z) + alpha * a1[0], h5 = bf_hi(old.z) + alpha * a1[1], h6 = bf_lo(old.w) + alpha * a1[2], h7 = bf_hi(old.w) + alpha * a1[3];
                    s += ((h0 * h0 + h1 * h1) + (h2 * h2 + h3 * h3)) + ((h4 * h4 + h5 * h5) + (h6 * h6 + h7 * h7));
                    u32x4 w; w.x = cvt_pk_bf16(h0, h1); w.y = cvt_pk_bf16(h2, h3); w.z = cvt_pk_bf16(h4, h5); w.w = cvt_pk_bf16(h6, h7);
                    *(PG8_GAS u32x4*)(hb + (size_t)row * 1024 + col0 + bj * HALF) = w; }
                s += __shfl_xor(s, 16); s += __shfl_xor(s, 32);
                if (ssq_next && fq == 0) (void)__hip_atomic_fetch_add(ssq_next + row, (ssq_t)(s * SSQ_SCALE), __ATOMIC_RELAXED, __HIP_MEMORY_SCOPE_AGENT); }
            asm volatile("" ::: "memory");
        }
    }
};
struct EpiQKV {
    static constexpr bool PERM = true, AFTER_DRAIN = false;
    bf16_t* qkv; float* F; const ssq_t* ssq; size_t seg_elems;
    __device__ __forceinline__ void operator()(const f32x4 (&acc)[2][2][4][2], const Unit& u, int wr, int wc, int fr, int fq) const {
        const int row0 = u.pm * BM + wr * 64 + fr;
        if (u.pn == 18) {
            if (wc == 0 && fq == 0) {
#pragma unroll
                for (int ai = 0; ai < 2; ++ai)
#pragma unroll
                    for (int m = 0; m < 4; ++m) { const int row = row0 + ai * HALF + m * 16; const float rs = rstd_of(ssq, row);
                        *(PG8_GAS f32x4*)(F + (size_t)row * 8) = acc[ai][0][m][0] * rs; *(PG8_GAS f32x4*)(F + (size_t)row * 8 + 4) = acc[ai][0][m][1] * rs; }
            }
            return;
        }
        const int seg = u.pn >> 1; bf16_t* dst = qkv + (size_t)seg * seg_elems; const float qs = (seg % 3 == 0) ? (0.125f * LOG2E) : 1.0f;
        const int col0 = (u.pn & 1) * BM + wc * 32 + 8 * fq;
        float rsv[2][4];
        rstd8(ssq, row0, qs, rsv);
#pragma unroll
        for (int ai = 0; ai < 2; ++ai)
#pragma unroll
            for (int m = 0; m < 4; ++m) { const int row = row0 + ai * HALF + m * 16; const float rs = rsv[ai][m]; bf16_t* rowp = dst + (size_t)row * 512 + col0;
#pragma unroll
                for (int bj = 0; bj < 2; ++bj) { const f32x4 v0 = acc[ai][bj][m][0] * rs, v1 = acc[ai][bj][m][1] * rs;
                    u32x4 w; w.x = cvt_pk_bf16(v0[0], v0[1]); w.y = cvt_pk_bf16(v0[2], v0[3]); w.z = cvt_pk_bf16(v1[0], v1[1]); w.w = cvt_pk_bf16(v1[2], v1[3]);
                    *(PG8_GAS u32x4*)(rowp + bj * HALF) = w; } }
    }
};
struct EpiGate {
    static constexpr bool PERM = true, AFTER_DRAIN = false;
    bf16_t* qkv; const ssq_t* ssq; size_t seg_elems;
    __device__ __forceinline__ void operator()(const f32x4 (&acc)[2][2][4][2], const Unit& u, int wr, int wc, int fr, int fq) const {
        const int row0 = u.pm * BM + wr * 64 + fr; const int br = u.pn >> 2; bf16_t* dst = qkv + (size_t)(3 * br + 1) * seg_elems;
        const int col0 = (u.pn & 3) * BM + wc * 32 + 8 * fq;
        float rsv[2][4];
        rstd8(ssq, row0, 1.0f, rsv);
#pragma unroll
        for (int ai = 0; ai < 2; ++ai)
#pragma unroll
            for (int m = 0; m < 4; ++m) { const int row = row0 + ai * HALF + m * 16; const float rsn = rsv[ai][m] * -LOG2E; bf16_t* rowp = dst + (size_t)row * 1024 + col0;
#pragma unroll
                for (int bj = 0; bj < 2; ++bj) { float h[8];
#pragma unroll
                    for (int n = 0; n < 2; ++n)
#pragma unroll
                        for (int j = 0; j < 4; ++j) h[4 * n + j] = __builtin_amdgcn_rcpf(1.0f + __builtin_amdgcn_exp2f(acc[ai][bj][m][n][j] * rsn));
                    u32x4 w; w.x = cvt_pk_bf16(h[0], h[1]); w.y = cvt_pk_bf16(h[2], h[3]); w.z = cvt_pk_bf16(h[4], h[5]); w.w = cvt_pk_bf16(h[6], h[7]);
                    *(PG8_GAS u32x4*)(rowp + bj * HALF) = w; } }
    }
};
struct EpiProj {
    static constexpr bool PERM = true, AFTER_DRAIN = false;
    const bf16_t* qkv; bf16_t* mb; size_t seg_elems;
    __device__ __forceinline__ void operator()(const f32x4 (&acc)[2][2][4][2], const Unit& u, int wr, int wc, int fr, int fq) const {
        const int br = u.pn >> 2, pm = u.pm - 384 * br, pn = u.pn & 3;
        const int row0 = pm * BM + wr * 64 + fr, col0 = pn * BM + wc * 32 + 8 * fq; const bf16_t* gate = qkv + (size_t)(3 * br + 1) * seg_elems;
#pragma unroll
        for (int ai = 0; ai < 2; ++ai) {
            u32x4 gpre[4][2], opre[4][2];
#pragma unroll
            for (int m = 0; m < 4; ++m) { const size_t off = (size_t)(row0 + ai * HALF + m * 16) * 1024 + col0;
#pragma unroll
                for (int bj = 0; bj < 2; ++bj) { gpre[m][bj] = *(const PG8_GAS u32x4*)(gate + off + bj * HALF); opre[m][bj] = (u32x4){0u, 0u, 0u, 0u}; if (br) opre[m][bj] = *(const PG8_GAS u32x4*)(mb + off + bj * HALF); } }
#pragma unroll
            for (int m = 0; m < 4; ++m) { const size_t off = (size_t)(row0 + ai * HALF + m * 16) * 1024 + col0;
#pragma unroll
                for (int bj = 0; bj < 2; ++bj) { const u32x4 gw = gpre[m][bj], old = opre[m][bj];
                    const f32x4 a0 = acc[ai][bj][m][0], a1 = acc[ai][bj][m][1]; u32x4 w;
                    w.x = cvt_pk_bf16(bf_lo(old.x) + bf_lo(gw.x) * a0[0], bf_hi(old.x) + bf_hi(gw.x) * a0[1]); w.y = cvt_pk_bf16(bf_lo(old.y) + bf_lo(gw.y) * a0[2], bf_hi(old.y) + bf_hi(gw.y) * a0[3]);
                    w.z = cvt_pk_bf16(bf_lo(old.z) + bf_lo(gw.z) * a1[0], bf_hi(old.z) + bf_hi(gw.z) * a1[1]); w.w = cvt_pk_bf16(bf_lo(old.w) + bf_lo(gw.w) * a1[2], bf_hi(old.w) + bf_hi(gw.w) * a1[3]);
                    *(PG8_GAS u32x4*)(mb + off + bj * HALF) = w; } }
            asm volatile("" ::: "memory");
        }
    }
};
struct ProjOrder {
    int G, c;
    __device__ bool next(int i, Unit& u) const { const int j = i / 3, br = i - 3 * j; int pm, pn;
        if (G == 256) { if (j >= 2) return false; pm = 64 * j + 8 * (c & 7) + (c >> 5); pn = (c >> 3) & 3; }
        else { const int T = c + G * j; if (T >= 512) return false; pm = T >> 2; pn = T & 3; }
        u.pm = pm + 384 * br; u.pn = pn + 4 * br; return true; }
    __device__ __forceinline__ void a_ready(const Unit&) const {}
    __device__ __forceinline__ void done(const Unit&) const {}
};
template <class Epi, class Sched, bool ALIGN_EPI = false, bool SP2 = false>
__device__ __forceinline__ void gemm_phase(PG8_LAS unsigned char* lds, const Gemm g, const Sched& S, const Epi& E) {
    int tid_l = threadIdx.x; asm volatile("" : "+v"(tid_l));
    const int tid = tid_l, wid = __builtin_amdgcn_readfirstlane(tid >> 6), lane = tid & 63, wr = wid >> 2, wc = wid & 3, fr = lane & 15, fq = lane >> 4;
    const int K = g.K, nt = K / BK;
    unsigned voffA[2], voffB[2];
#pragma unroll
    for (int i = 0; i < 2; ++i) { int R, C; stage_rc(tid * 16 + i * 8192, R, C); const int Rb = Epi::PERM ? ((R & ~31) + perm32(R & 31)) : R;
        voffA[i] = (unsigned)(R * K + C) * 2u; voffB[i] = (unsigned)(Rb * K + C) * 2u; }
    const size_t kstep = (size_t)(BK * 2);
    const size_t hstep = (size_t)HALF * K * 2;
    const size_t tstep = 2 * hstep;
    const unsigned ldsw = (unsigned)wid * 1024u;
    const int aoff = lds_byte(wr * 64 + fr, fq * 8), boff = lds_byte(wc * 32 + fr, fq * 8);
#define PG8_SA(b, h) (((b) * 2 + (h)) * HTB)
#define PG8_SB(b, h) ((4 + (b) * 2 + (h)) * HTB)
#define PG8_STAGE(bufoff, gbase, voff) do { _Pragma("unroll") for (int _i = 0; _i < 2; ++_i) \
        __builtin_amdgcn_global_load_lds((const unsigned*)((const char*)(gbase) + (voff)[_i]), (PG8_LAS unsigned*)(lds + (bufoff) + ldsw + _i * 8192), 16, 0, 0); } while (0)
#define PG8_LDA(dst, b, h) do { _Pragma("unroll") for (int m = 0; m < 4; ++m) _Pragma("unroll") for (int k = 0; k < 2; ++k) dst[m][k] = *(const PG8_LAS bf16x8*)(lds + PG8_SA(b, h) + aoff + m * 2048 + k * 1024); } while (0)
#define PG8_LDB(dst, b, h) do { _Pragma("unroll") for (int n = 0; n < 2; ++n) _Pragma("unroll") for (int k = 0; k < 2; ++k) dst[n][k] = *(const PG8_LAS bf16x8*)(lds + PG8_SB(b, h) + boff + n * 2048 + k * 1024); } while (0)
#define PG8_MMA(ai, bj, At, Bt) do { __builtin_amdgcn_s_setprio(1); _Pragma("unroll") for (int m = 0; m < 4; ++m) _Pragma("unroll") for (int n = 0; n < 2; ++n) _Pragma("unroll") for (int k = 0; k < 2; ++k) \
        acc[ai][bj][m][n] = __builtin_amdgcn_mfma_f32_16x16x32_bf16(Bt[n][k], At[m][k], acc[ai][bj][m][n], 0, 0, 0); __builtin_amdgcn_s_setprio(0); } while (0)
#define PG8_WAIT_V(n) asm volatile("s_waitcnt vmcnt(" #n ")" ::: "memory")
#define PG8_WAIT_L(n) asm volatile("s_waitcnt lgkmcnt(" #n ")" ::: "memory")
#define PG8_BAR __builtin_amdgcn_s_barrier()
#define PG8_SCHED __builtin_amdgcn_sched_barrier(0)
    Unit cur, nxt; int ui = 0;
    if (!S.next(0, cur)) return;
    f32x4 acc[2][2][4][2];
#pragma unroll
    for (int a = 0; a < 2; ++a)
#pragma unroll
        for (int b = 0; b < 2; ++b)
#pragma unroll
            for (int m = 0; m < 4; ++m)
#pragma unroll
                for (int n = 0; n < 2; ++n) acc[a][b][m][n] = (f32x4){0.f, 0.f, 0.f, 0.f};
    bf16x8 At[4][2], B0[2][2], B1[2][2];
    const char* cA = (const char*)g.A + (size_t)cur.pm * tstep; const char* cB = (const char*)g.Bt + (size_t)cur.pn * tstep;
    S.a_ready(cur);
    if constexpr (SP2) {
        PG8_STAGE(PG8_SB(0, 0), cB, voffB); PG8_STAGE(PG8_SB(0, 1), cB + hstep, voffB); PG8_STAGE(PG8_SA(0, 0), cA, voffA); PG8_STAGE(PG8_SA(0, 1), cA + hstep, voffA);
        if (wr == 1) PG8_BAR;
        PG8_WAIT_V(2); PG8_BAR;
        PG8_STAGE(PG8_SB(1, 0), cB + kstep, voffB); PG8_STAGE(PG8_SA(1, 0), cA + kstep, voffA); PG8_STAGE(PG8_SB(1, 1), cB + hstep + kstep, voffB);
        PG8_WAIT_V(6); PG8_BAR;
    } else {
        PG8_STAGE(PG8_SB(0, 0), cB, voffB); PG8_STAGE(PG8_SA(0, 0), cA, voffA); PG8_STAGE(PG8_SB(0, 1), cB + hstep, voffB); PG8_STAGE(PG8_SA(0, 1), cA + hstep, voffA);
        if (wr == 1) PG8_BAR;
        PG8_WAIT_V(4); PG8_BAR;
        PG8_STAGE(PG8_SB(1, 0), cB + kstep, voffB); PG8_STAGE(PG8_SA(1, 0), cA + kstep, voffA); PG8_STAGE(PG8_SB(1, 1), cB + hstep + kstep, voffB);
        PG8_WAIT_V(6); PG8_BAR;
    }
    for (;;) {
        const bool has_next = S.next(ui + 1, nxt);
        const char* nA = has_next ? (const char*)g.A + (size_t)nxt.pm * tstep : cA; const char* nB = has_next ? (const char*)g.Bt + (size_t)nxt.pn * tstep : cB;
        for (int t = 0; t < nt; t += 2) {
            const bool last = (t == nt - 2);
            const char* a1 = cA + (size_t)(t + 1) * kstep;
            const char* a2 = last ? nA : cA + (size_t)(t + 2) * kstep; const char* b2 = last ? nB : cB + (size_t)(t + 2) * kstep;
            const char* a3 = a2 + kstep; const char* b3 = b2 + kstep;
            if (last && has_next) S.a_ready(nxt);
            if constexpr (SP2) {
            PG8_LDB(B0, 0, 0); PG8_LDB(B1, 0, 1); PG8_SCHED; PG8_LDA(At, 0, 0); PG8_STAGE(PG8_SA(1, 1), a1 + hstep, voffA);
            PG8_WAIT_V(8); PG8_WAIT_L(0); PG8_BAR; PG8_MMA(0, 0, At, B0); PG8_MMA(0, 1, At, B1); PG8_BAR; PG8_SCHED;
            PG8_LDA(At, 0, 1); PG8_STAGE(PG8_SB(0, 0), b2, voffB); PG8_STAGE(PG8_SB(0, 1), b2 + hstep, voffB); PG8_STAGE(PG8_SA(0, 0), a2, voffA);
            PG8_WAIT_V(8); PG8_WAIT_L(0); PG8_BAR; PG8_MMA(1, 0, At, B0); PG8_MMA(1, 1, At, B1); PG8_BAR; PG8_SCHED;
            PG8_LDB(B0, 1, 0); PG8_LDB(B1, 1, 1); PG8_SCHED; PG8_LDA(At, 1, 0); PG8_STAGE(PG8_SA(0, 1), a2 + hstep, voffA);
            PG8_WAIT_V(8); PG8_WAIT_L(0); PG8_BAR; PG8_MMA(0, 0, At, B0); PG8_MMA(0, 1, At, B1); PG8_BAR; PG8_SCHED;
            PG8_LDA(At, 1, 1); PG8_STAGE(PG8_SB(1, 0), b3, voffB); PG8_STAGE(PG8_SB(1, 1), b3 + hstep, voffB); PG8_STAGE(PG8_SA(1, 0), a3, voffA);
            PG8_WAIT_V(8); PG8_WAIT_L(0); PG8_BAR; PG8_MMA(1, 0, At, B0); PG8_MMA(1, 1, At, B1); PG8_BAR; PG8_SCHED;
            } else {
            PG8_LDB(B0, 0, 0); PG8_SCHED; PG8_LDA(At, 0, 0); PG8_STAGE(PG8_SA(1, 1), a1 + hstep, voffA);
            PG8_WAIT_L(8); PG8_BAR; PG8_WAIT_L(0); PG8_MMA(0, 0, At, B0); PG8_BAR; PG8_SCHED;
            PG8_LDB(B1, 0, 1); PG8_STAGE(PG8_SB(0, 0), b2, voffB);
            PG8_BAR; PG8_WAIT_L(0); PG8_MMA(0, 1, At, B1); PG8_BAR;
            PG8_LDA(At, 0, 1); PG8_STAGE(PG8_SA(0, 0), a2, voffA);
            PG8_BAR; PG8_WAIT_L(0); PG8_MMA(1, 0, At, B0); PG8_BAR; PG8_SCHED;
            PG8_STAGE(PG8_SB(0, 1), b2 + hstep, voffB);
            PG8_WAIT_V(6); PG8_BAR; PG8_MMA(1, 1, At, B1); PG8_BAR;
            PG8_LDB(B0, 1, 0); PG8_SCHED; PG8_LDA(At, 1, 0); PG8_STAGE(PG8_SA(0, 1), a2 + hstep, voffA);
            PG8_WAIT_L(8); PG8_BAR; PG8_WAIT_L(0); PG8_MMA(0, 0, At, B0); PG8_BAR; PG8_SCHED;
            PG8_LDB(B1, 1, 1); PG8_STAGE(PG8_SB(1, 0), b3, voffB);
            PG8_BAR; PG8_WAIT_L(0); PG8_MMA(0, 1, At, B1); PG8_BAR;
            PG8_LDA(At, 1, 1); PG8_STAGE(PG8_SA(1, 0), a3, voffA);
            PG8_BAR; PG8_WAIT_L(0); PG8_MMA(1, 0, At, B0); PG8_BAR; PG8_SCHED;
            PG8_STAGE(PG8_SB(1, 1), b3 + hstep, voffB);
            PG8_WAIT_V(6); PG8_BAR; PG8_MMA(1, 1, At, B1); PG8_BAR;
            }
        }
        if constexpr (ALIGN_EPI) { if (wr == 0) PG8_BAR; }
        if constexpr (!Epi::AFTER_DRAIN) { E(acc, cur, wr, wc, fr, fq); S.done(cur); }
        if (!has_next) break;
#pragma unroll
        for (int a = 0; a < 2; ++a)
#pragma unroll
            for (int b = 0; b < 2; ++b)
#pragma unroll
                for (int m = 0; m < 4; ++m)
#pragma unroll
                    for (int n = 0; n < 2; ++n) acc[a][b][m][n] = (f32x4){0.f, 0.f, 0.f, 0.f};
        cur = nxt; cA = nA; cB = nB; ++ui;
        if constexpr (ALIGN_EPI) { if (wr == 1) PG8_BAR; }
    }
    PG8_WAIT_V(0);
    if constexpr (!ALIGN_EPI) { if (wr == 0) PG8_BAR; }
    PG8_BAR;
    if constexpr (Epi::AFTER_DRAIN) { E.fused(acc, cur, wr, wc, fr, fq, lds, wid, lane); S.done(cur); }
#undef PG8_SA
#undef PG8_SB
#undef PG8_STAGE
#undef PG8_LDA
#undef PG8_LDB
#undef PG8_MMA
#undef PG8_WAIT_V
#undef PG8_WAIT_L
#undef PG8_BAR
#undef PG8_SCHED
}
}
#define PG8_SP2 true
#define PG8_ALIGN true
#include <hip/hip_bf16.h>
#include <cmath>
namespace attn_body {
using bf16=__hip_bfloat16;
using bf16x8=__attribute__((ext_vector_type(8)))short;
using s16x4=__attribute__((ext_vector_type(4)))short;
using f32x16=__attribute__((ext_vector_type(16)))float;
using u32x4=__attribute__((ext_vector_type(4)))unsigned;
constexpr int SEQ=2048,D=64,DM=512;
constexpr int NW=8,QBLK=32,QB=QBLK*NW,KVBLK=64,NQB=SEQ/QB;
constexpr int ATTN_PITCH=DM, ATTN_UNIT_ROWS=QB;
__device__ __forceinline__ int crow(int r,int hi){return (r&3)+8*(r>>2)+4*hi;}
#define SBAR() __builtin_amdgcn_sched_barrier(0)
__device__ __forceinline__ void cmask(f32x16&p0,f32x16&p1,int jb,int qrel,int hi){
  const float NEG=-INFINITY; int kb=64*jb+4*hi;
  #pragma unroll
  for(int r=0;r<16;++r){int kv=kb+(r&3)+8*(r>>2); if(kv>qrel)p0[r]=NEG; if(kv+32>qrel)p1[r]=NEG;}
}

constexpr int NSLOT=3, SLOTB=8192;
constexpr int LDS_K=0, LDS_V=NSLOT*SLOTB, LDS_WS=2*NSLOT*SLOTB, LDS_OST=LDS_WS+NW*64*4, LDS_BYTES=LDS_OST+NW*4096;
constexpr float C2=0.125f*1.4426950408889634f;
__device__ __forceinline__ void glds16(const void*gsrc,unsigned lds_dst){unsigned keep;
  asm volatile("s_mov_b32 %0, m0\n\ts_mov_b32 m0, %2\n\ts_nop 0\n\tglobal_load_lds_dwordx4 %1, off\n\ts_mov_b32 m0, %0":"=&s"(keep):"v"(gsrc),"s"(lds_dst):"memory");}
__device__ __forceinline__ float max3f(float a,float b,float c){float r;asm("v_max3_f32 %0, %1, %2, %3":"=v"(r):"v"(a),"v"(b),"v"(c));return r;}
__device__ __forceinline__ float max2f(float a,float b){float r;asm("v_max_f32_e32 %0, %1, %2":"=v"(r):"v"(a),"v"(b));return r;}
__device__ __forceinline__ float fadd_s(float a,float b){float r;asm("v_add_f32_e32 %0, %1, %2":"=v"(r):"v"(a),"v"(b));return r;}
__device__ __forceinline__ float fsub_s(float a,float b){float r;asm("v_sub_f32_e32 %0, %1, %2":"=v"(r):"v"(a),"v"(b));return r;}
typedef float f32x2_t __attribute__((ext_vector_type(2))); typedef __bf16 bf16x2_t __attribute__((ext_vector_type(2)));
__device__ __forceinline__ unsigned cvtpk_s(float lo,float hi){f32x2_t v={lo,hi};bf16x2_t b=__builtin_convertvector(v,bf16x2_t);return __builtin_bit_cast(unsigned,b);}
#define WAIT_BAR(N) asm volatile("s_waitcnt vmcnt(" #N ") lgkmcnt(0)\n\ts_barrier":::"memory")

__device__ __forceinline__ void qkt(f32x16&p0,f32x16&p1,const char*Kslot,const bf16x8*qr,const f32x16&negm,int r32,int hi){
  const char*kb=Kslot+hi*1024+r32*16;
  #pragma unroll
  for(int d0=0;d0<4;++d0){
    const bf16x8 b0=*reinterpret_cast<const bf16x8*>(kb+d0*2048);
    const bf16x8 b1=*reinterpret_cast<const bf16x8*>(kb+d0*2048+512);
    if(d0==0){p0=__builtin_amdgcn_mfma_f32_32x32x16_bf16(b0,qr[0],negm,0,0,0);p1=__builtin_amdgcn_mfma_f32_32x32x16_bf16(b1,qr[0],negm,0,0,0);}
    else{p0=__builtin_amdgcn_mfma_f32_32x32x16_bf16(b0,qr[d0],p0,0,0,0);p1=__builtin_amdgcn_mfma_f32_32x32x16_bf16(b1,qr[d0],p1,0,0,0);}}
}
typedef __attribute__((address_space(3))) const char* lds_cptr;
typedef short v4i16_t __attribute__((ext_vector_type(4)));
__device__ __forceinline__ void kload8(bf16x8*kf,lds_cptr kp){
  kf[0]=*(const __attribute__((address_space(3))) bf16x8*)(kp);      kf[1]=*(const __attribute__((address_space(3))) bf16x8*)(kp+512);
  kf[2]=*(const __attribute__((address_space(3))) bf16x8*)(kp+2048); kf[3]=*(const __attribute__((address_space(3))) bf16x8*)(kp+2560);
  kf[4]=*(const __attribute__((address_space(3))) bf16x8*)(kp+4096); kf[5]=*(const __attribute__((address_space(3))) bf16x8*)(kp+4608);
  kf[6]=*(const __attribute__((address_space(3))) bf16x8*)(kp+6144); kf[7]=*(const __attribute__((address_space(3))) bf16x8*)(kp+6656);
}
__device__ __forceinline__ void kload2(bf16x8*kf,lds_cptr kp,int j){ kf[2*j]=*(const __attribute__((address_space(3))) bf16x8*)(kp+j*2048); kf[2*j+1]=*(const __attribute__((address_space(3))) bf16x8*)(kp+j*2048+512); }
__device__ __forceinline__ s16x4 vtr(lds_cptr p){ return __builtin_bit_cast(s16x4,__builtin_amdgcn_ds_read_tr16_b64_v4i16((__attribute__((address_space(3))) v4i16_t*)p)); }
__device__ __forceinline__ float rowmax(const f32x16&p0,const f32x16&p1){
  float a=max3f(p0[0],p0[1],p1[0]),b=max3f(p0[2],p0[3],p1[1]);a=max3f(a,p1[2],p1[3]);
  #pragma unroll
  for(int r=4;r<16;r+=4){a=max3f(a,p0[r],p0[r+1]);b=max3f(b,p0[r+2],p0[r+3]);a=max3f(a,p1[r],p1[r+1]);b=max3f(b,p1[r+2],p1[r+3]);}
  const float m=max2f(a,b);
  auto rr=__builtin_amdgcn_permlane32_swap(__float_as_uint(m),__float_as_uint(m),false,false);
  return max2f(__uint_as_float(rr[0]),__uint_as_float(rr[1]));
}
__device__ __forceinline__ void pv(f32x16*o,int vb,bf16x8 pa0,bf16x8 pa1,bf16x8 pa2,bf16x8 pa3){
  #pragma unroll
  for(int d0=0;d0<2;++d0){s16x4 lo[4],hi[4];
    #pragma unroll
    for(int ks=0;ks<4;++ks){
      asm volatile("ds_read_b64_tr_b16 %0,%1 offset:%c2":"=&v"(lo[ks]):"v"(vb),"i"(d0*4096+ks*1024):"memory");
      asm volatile("ds_read_b64_tr_b16 %0,%1 offset:%c2":"=&v"(hi[ks]):"v"(vb),"i"(d0*4096+ks*1024+512):"memory");}
    asm volatile("s_waitcnt lgkmcnt(0)":::"memory");SBAR();
    #define PK(k) (bf16x8){lo[k][0],lo[k][1],lo[k][2],lo[k][3],hi[k][0],hi[k][1],hi[k][2],hi[k][3]}
    o[d0]=__builtin_amdgcn_mfma_f32_32x32x16_bf16(pa0,PK(0),o[d0],0,0,0);
    o[d0]=__builtin_amdgcn_mfma_f32_32x32x16_bf16(pa1,PK(1),o[d0],0,0,0);
    o[d0]=__builtin_amdgcn_mfma_f32_32x32x16_bf16(pa2,PK(2),o[d0],0,0,0);
    o[d0]=__builtin_amdgcn_mfma_f32_32x32x16_bf16(pa3,PK(3),o[d0],0,0,0);
    #undef PK
  }
}

#ifndef ATTN_STORE16
#define ATTN_STORE16(p,v) (*(__attribute__((address_space(1))) u32x4*)(p)=(v))
#endif
typedef __attribute__((address_space(3))) const float* lds_fptr;
typedef float f32x4a __attribute__((ext_vector_type(4)));
typedef __attribute__((address_space(3))) const f32x4a* lds_f4ptr;
constexpr int LDS_TAB=LDS_BYTES;
constexpr int LDS_ATT_TOTAL=LDS_TAB+SEQ*4;
__device__ __forceinline__ void qkt2(f32x16&p0,f32x16&p1,lds_cptr Kslot,const bf16x8*qr,int r32,int hi){
  const lds_cptr kb=Kslot+hi*1024+r32*16;
  #pragma unroll
  for(int d0=0;d0<4;++d0){
    const bf16x8 b0=*(const __attribute__((address_space(3))) bf16x8*)(kb+d0*2048);
    const bf16x8 b1=*(const __attribute__((address_space(3))) bf16x8*)(kb+d0*2048+512);
    p0=__builtin_amdgcn_mfma_f32_32x32x16_bf16(b0,qr[d0],p0,0,0,0);p1=__builtin_amdgcn_mfma_f32_32x32x16_bf16(b1,qr[d0],p1,0,0,0);}
}
template<int THRL,int MODE> __device__ __forceinline__ void attn_unit(int qb,int t0,const bf16*Qh,const bf16*__restrict__ Kh,const bf16*__restrict__ Vh,bf16*Oh,float sl2,const float*gtab,char*shm){
  int tid_l=threadIdx.x; asm volatile("":"+v"(tid_l)); const int tid=tid_l,lane=tid&63,r32=lane&31,hi=lane>>5; const int wid=__builtin_amdgcn_readfirstlane(tid>>6);
  const int q0=qb*QB;
  const bf16*Qw=Qh+(long)(q0+wid*QBLK)*DM;
  const unsigned lds0=(unsigned)(uintptr_t)shm;
  float*wsf=(float*)(shm+LDS_WS)+wid*64;
  const bf16*ksrc=Kh+(long)(t0*KVBLK+lane)*DM+wid*8;
  const bf16*vsrc=Vh+(long)(t0*KVBLK+16*(wid&3)+(lane>>2))*DM+(wid>>2)*32+(lane&3)*8;
  const unsigned kdst=lds0+LDS_K+wid*1024, vdst=lds0+LDS_V+wid*1024;
  #define DMA_K(t,slot) glds16(ksrc+(long)(t)*KVBLK*DM,(unsigned)__builtin_amdgcn_readfirstlane(kdst+(slot)))
  #define DMA_V(t,slot) glds16(vsrc+(long)(t)*KVBLK*DM,(unsigned)__builtin_amdgcn_readfirstlane(vdst+(slot)))
  const int vb0=(int)(lds0+LDS_V)+((lane>>4)&1)*32+(lane&3)*8+(4*hi+((lane&15)>>2))*64;
  bf16x8 kf[8];
  const lds_cptr shm3=(lds_cptr)shm; const lds_cptr kp0=shm3+LDS_K+hi*1024+r32*16; const lds_cptr vp0=shm3+LDS_V+((lane>>4)&1)*32+(lane&3)*8+(4*hi+((lane&15)>>2))*64;
  const lds_fptr tab3=(lds_fptr)(shm3+LDS_TAB)+64*t0;
  const int NT=(q0+QB)/KVBLK-t0;
  DMA_K(0,0);DMA_V(0,0);DMA_K(1,SLOTB);
  if constexpr(MODE==1){
    __attribute__((address_space(3))) float*tw=(__attribute__((address_space(3))) float*)((__attribute__((address_space(3))) char*)shm+LDS_TAB);
    for(int i=tid;i<q0+QB;i+=NW*64)tw[i]=gtab[i];
  }
  bf16x8 qr[4];
  #pragma unroll
  for(int d0=0;d0<4;++d0)qr[d0]=*reinterpret_cast<const bf16x8*>(&Qw[(long)r32*DM+d0*16+hi*8]);
  float mhat=0.f,l_reg=0.f;f32x16 o[2];o[0]=f32x16{};o[1]=f32x16{};
  const int qrel=wid*QBLK+r32;
  #define CMASK(P0,P1,t) do{int jb_=(t)-(NT-4); if(jb_>=0)cmask(P0,P1,jb_,qrel,hi);}while(0)
  #define CINIT(C0,C1,t) do{ if constexpr(MODE==0){ const float base_=__builtin_fmaf(sl2,(float)(64*(t)+4*hi),-mhat); \
      _Pragma("unroll") for(int r=0;r<16;++r){ C0[r]=__builtin_fmaf(sl2,(float)((r&3)+8*(r>>2)),base_); C1[r]=__builtin_fmaf(sl2,(float)((r&3)+8*(r>>2)+32),base_);} } \
    else { const lds_f4ptr tb_=(lds_f4ptr)(tab3+64*(t)+4*hi); \
      _Pragma("unroll") for(int g=0;g<4;++g){ const f32x4a a_=tb_[2*g], b_=tb_[2*g+8]; \
        _Pragma("unroll") for(int j=0;j<4;++j){ C0[4*g+j]=a_[j]-mhat; C1[4*g+j]=b_[j]-mhat; } } } }while(0)
  bool resc=false;
  #define START(P0,P1) do{ const float rm=rowmax(P0,P1); resc=false; \
    { const float dl=max2f(rm,0.f); mhat=fadd_s(mhat,dl); \
      _Pragma("unroll") for(int r=0;r<16;++r){P0[r]=fsub_s(P0[r],dl);P1[r]=fsub_s(P1[r],dl);} } \
    _Pragma("unroll") for(int r=0;r<16;++r)P0[r]=__builtin_amdgcn_exp2f(P0[r]); }while(0)
  #define RESC() do{ if(resc){ asm volatile("s_waitcnt lgkmcnt(0)":::"memory"); \
      _Pragma("unroll") for(int d_=0;d_<2;++d_) _Pragma("unroll") for(int r=0;r<16;++r)o[d_][r]*=wsf[crow(r,hi)]; } }while(0)
  f32x16 pA0,pA1,pB0,pB1;
  int sl_prev=0,sl_cur=0,sl_next=SLOTB;
  #define ROT() do{sl_prev=sl_cur;sl_cur=sl_next;sl_next=(sl_next==(NSLOT-1)*SLOTB)?0:sl_next+SLOTB;}while(0)
  DMA_K(2,2*SLOTB);
  WAIT_BAR(3);
  if constexpr(MODE==0) mhat=sl2*(float)(q0+qrel-64*t0); else mhat=tab3[q0+qrel-64*t0];
  CINIT(pA0,pA1,0);
  qkt2(pA0,pA1,shm3+LDS_K,qr,r32,hi);asm volatile("s_nop 15\n\ts_nop 7":"+v"(pA0),"+v"(pA1));CMASK(pA0,pA1,0);
  START(pA0,pA1);
  _Pragma("unroll") for(int r=0;r<16;++r)pA1[r]=__builtin_amdgcn_exp2f(pA1[r]);
  WAIT_BAR(0);
  DMA_K(3,0);DMA_V(1,SLOTB);
  ROT();
  kload8(kf,kp0+sl_cur);
  WAIT_BAR(2);
  s16x4 vlo[8],vhi[8]; u32x4 pw0,pw1,pw2,pw3;
  #define PKW(P,B) cvtpk_s(P[B],P[B+1])
  #define PAF(k) __builtin_bit_cast(bf16x8,pw##k)
  #define VFR(i) (bf16x8){vlo[i][0],vlo[i][1],vlo[i][2],vlo[i][3],vhi[i][0],vhi[i][1],vhi[i][2],vhi[i][3]}
  #define PIN(x) asm volatile("":"+v"(x))
  #define MX3(a,b,c) __builtin_fmaxf(__builtin_fmaxf((a),(b)),(c))
  #define GAPA(MF,A0,A1,A2,A3,W0,W1,PW) do{ MF; sacc+=A0; sacc+=A1; sacc+=A2; sacc+=A3; PIN(sacc); W0; W1; PIN(PW); SBAR(); }while(0)
  #define EX(v) __builtin_amdgcn_exp2f(v)
  #define GAPB(MF,X,B) do{ MF; X[B]=EX(X[B]); X[B+1]=EX(X[B+1]); X[B+2]=EX(X[B+2]); X[B+3]=EX(X[B+3]); PIN(X); SBAR(); }while(0)
  #define VRD(i) do{ vlo[i]=vtr(vp_+(((i)>>2)*4096+((i)&3)*1024)); vhi[i]=vtr(vp_+(((i)>>2)*4096+((i)&3)*1024+512)); }while(0)
  #define KRD(G,j) do{ if(G){ kload2(kf,kp0+sl_next,j); SBAR(); } }while(0)
  #define STEP(C0,C1,P0,P1,t,GK,GV,GL) do{ CINIT(C0,C1,t); SBAR(); \
    const lds_cptr vp_=vp0+sl_prev; \
    VRD(0); SBAR(); float sacc=(P0[0]+P0[1]); \
    GAPA(C0=__builtin_amdgcn_mfma_f32_32x32x16_bf16(kf[0],qr[0],C0,0,0,0), P0[2],P0[3],P0[4],P0[5],     pw0[0]=PKW(P0,0), pw0[1]=PKW(P0,2), pw0); \
    VRD(4); SBAR(); GAPA(C1=__builtin_amdgcn_mfma_f32_32x32x16_bf16(kf[1],qr[0],C1,0,0,0), P0[6],P0[7],P0[8],P0[9],     pw0[2]=PKW(P0,4), pw0[3]=PKW(P0,6), pw0); \
    VRD(1); SBAR(); GAPA(C0=__builtin_amdgcn_mfma_f32_32x32x16_bf16(kf[2],qr[1],C0,0,0,0),   P0[10],P0[11],P0[12],P0[13], pw1[0]=PKW(P0,8), pw1[1]=PKW(P0,10), pw1); \
    VRD(5); SBAR(); GAPA(C1=__builtin_amdgcn_mfma_f32_32x32x16_bf16(kf[3],qr[1],C1,0,0,0),   P0[14],P0[15],P1[0],P1[1],   pw1[2]=PKW(P0,12),pw1[3]=PKW(P0,14), pw1); \
    VRD(2); SBAR(); GAPA(C0=__builtin_amdgcn_mfma_f32_32x32x16_bf16(kf[4],qr[2],C0,0,0,0),   P1[2],P1[3],P1[4],P1[5],     pw2[0]=PKW(P1,0), pw2[1]=PKW(P1,2), pw2); \
    VRD(6); SBAR(); GAPA(C1=__builtin_amdgcn_mfma_f32_32x32x16_bf16(kf[5],qr[2],C1,0,0,0),   P1[6],P1[7],P1[8],P1[9],     pw2[2]=PKW(P1,4), pw2[3]=PKW(P1,6), pw2); \
    VRD(3); SBAR(); GAPA(C0=__builtin_amdgcn_mfma_f32_32x32x16_bf16(kf[6],qr[3],C0,0,0,0),   P1[10],P1[11],P1[12],P1[13], pw3[0]=PKW(P1,8), pw3[1]=PKW(P1,10), pw3); \
    VRD(7); SBAR(); GAPA(C1=__builtin_amdgcn_mfma_f32_32x32x16_bf16(kf[7],qr[3],C1,0,0,0),   P1[14],P1[15],0.f,0.f,       pw3[2]=PKW(P1,12),pw3[3]=PKW(P1,14), pw3); \
    l_reg+=sacc; \
    if(GK){DMA_K((t)+3,sl_cur);} if(GV){DMA_V((t)+1,sl_next);} \
    CMASK(C0,C1,t); \
    { float a=MX3(C0[0],C0[1],C1[0]),b=MX3(C0[2],C0[3],C1[1]); a=MX3(a,C1[2],C1[3]); \
      _Pragma("unroll") for(int r=4;r<16;r+=4){a=MX3(a,C0[r],C0[r+1]);b=MX3(b,C0[r+2],C0[r+3]);a=MX3(a,C1[r],C1[r+1]);b=MX3(b,C1[r+2],C1[r+3]);} \
      float rm=__builtin_fmaxf(a,b); { auto rr=__builtin_amdgcn_permlane32_swap(__float_as_uint(rm),__float_as_uint(rm),false,false); rm=__builtin_fmaxf(__uint_as_float(rr[0]),__uint_as_float(rr[1])); } \
      resc=false; \
      if(__builtin_expect(__any(rm>(float)THRL),0)){ const float dl=__builtin_fmaxf(rm,0.f); mhat+=dl; \
        _Pragma("unroll") for(int r=0;r<16;++r){C0[r]-=dl;C1[r]-=dl;} \
        const float f=__builtin_amdgcn_exp2f(-dl); l_reg*=f; if(hi==0)wsf[r32]=f; resc=true; } } \
    SBAR(); \
    GAPB(o[0]=__builtin_amdgcn_mfma_f32_32x32x16_bf16(PAF(0),VFR(0),o[0],0,0,0), C0,0); \
    GAPB(o[1]=__builtin_amdgcn_mfma_f32_32x32x16_bf16(PAF(0),VFR(4),o[1],0,0,0), C0,4); \
    KRD(GL,0); GAPB(o[0]=__builtin_amdgcn_mfma_f32_32x32x16_bf16(PAF(1),VFR(1),o[0],0,0,0), C0,8); \
    KRD(GL,1); GAPB(o[1]=__builtin_amdgcn_mfma_f32_32x32x16_bf16(PAF(1),VFR(5),o[1],0,0,0), C0,12); \
    KRD(GL,2); GAPB(o[0]=__builtin_amdgcn_mfma_f32_32x32x16_bf16(PAF(2),VFR(2),o[0],0,0,0), C1,0); \
    KRD(GL,3); GAPB(o[1]=__builtin_amdgcn_mfma_f32_32x32x16_bf16(PAF(2),VFR(6),o[1],0,0,0), C1,4); \
    GAPB(o[0]=__builtin_amdgcn_mfma_f32_32x32x16_bf16(PAF(3),VFR(3),o[0],0,0,0), C1,8); \
    GAPB(o[1]=__builtin_amdgcn_mfma_f32_32x32x16_bf16(PAF(3),VFR(7),o[1],0,0,0), C1,12); \
    }while(0)
  int t=1;
  #undef CMASK
  #define CMASK(P0,P1,t) do{}while(0)
  for(;t+5<NT;t+=2){
    STEP(pB0,pB1,pA0,pA1,t,true,true,true);     WAIT_BAR(2); RESC(); ROT();
    STEP(pA0,pA1,pB0,pB1,t+1,true,true,true);   WAIT_BAR(2); RESC(); ROT();
  }
  #undef CMASK
  #define CMASK(P0,P1,t) do{int jb_=(t)-(NT-4); if(jb_>=0)cmask(P0,P1,jb_,qrel,hi);}while(0)
  #define ENDW(tt) do{ if((tt)+3<NT){WAIT_BAR(2);} else if((tt)+2<NT){WAIT_BAR(1);} else {WAIT_BAR(0);} }while(0)
  for(;t+1<NT;t+=2){
    STEP(pB0,pB1,pA0,pA1,t,(t+3<NT),(t+1<NT),(t+1<NT));       ENDW(t);   RESC(); ROT();
    STEP(pA0,pA1,pB0,pB1,t+1,(t+4<NT),(t+2<NT),(t+2<NT));     ENDW(t+1); RESC(); ROT();
  }
  STEP(pB0,pB1,pA0,pA1,NT-1,false,false,false); RESC();
  { float sacc=pB0[0]+pB0[1]; _Pragma("unroll") for(int r=2;r<16;++r)sacc+=pB0[r]; _Pragma("unroll") for(int r=0;r<16;++r)sacc+=pB1[r]; l_reg+=sacc;
    pw0=(u32x4){PKW(pB0,0),PKW(pB0,2),PKW(pB0,4),PKW(pB0,6)};pw1=(u32x4){PKW(pB0,8),PKW(pB0,10),PKW(pB0,12),PKW(pB0,14)};pw2=(u32x4){PKW(pB1,0),PKW(pB1,2),PKW(pB1,4),PKW(pB1,6)};pw3=(u32x4){PKW(pB1,8),PKW(pB1,10),PKW(pB1,12),PKW(pB1,14)};
    SBAR(); pv(o,vb0+sl_cur,PAF(0),PAF(1),PAF(2),PAF(3)); }
  #undef GAPA
  #undef GAPB
  #undef EX
  #undef VRD
  #undef KRD
  #undef STEP
  #undef ENDW
  #undef MX3
  #undef PIN
  #undef VFR
  {auto rr=__builtin_amdgcn_permlane32_swap(__float_as_uint(l_reg),__float_as_uint(l_reg),false,false);l_reg=__uint_as_float(rr[0])+__uint_as_float(rr[1]);}
  if(hi==0)wsf[32+r32]=l_reg;asm volatile("s_waitcnt lgkmcnt(0)":::"memory");
  float rli[16];
  #pragma unroll
  for(int r=0;r<16;++r)rli[r]=__builtin_amdgcn_rcpf(wsf[32+crow(r,hi)]);
  bf16*Ow=Oh+(long)(q0+wid*QBLK)*DM;
  { bf16*stg=(bf16*)(shm+LDS_OST)+wid*2048;
    #pragma unroll
    for(int r=0;r<16;++r){const int orow=crow(r,hi);
      #pragma unroll
      for(int d0=0;d0<2;++d0)((unsigned short*)stg)[orow*64+d0*32+r32]=(unsigned short)cvtpk_s(o[d0][r]*rli[r],0.f);}
    asm volatile("s_waitcnt lgkmcnt(0)":::"memory");
    #pragma unroll
    for(int i=0;i<4;++i){const int row=i*8+(lane>>3),ch=lane&7; const u32x4 v=*(const u32x4*)(stg+row*64+ch*8); ATTN_STORE16(Ow+(long)row*DM+ch*8,v);} }
  asm volatile("s_waitcnt lgkmcnt(0)\n\ts_barrier":::"memory");
  #undef CMASK
  #undef CINIT
  #undef START
  #undef RESC
  #undef ROT
}

__device__ __forceinline__ void sb_unit(int qb,const bf16*Qh,const bf16*__restrict__ Kh,const bf16*__restrict__ Vh,bf16*Oh,char*shm){
  int tid_l=threadIdx.x; asm volatile("":"+v"(tid_l)); const int tid=tid_l,lane=tid&63,r32=lane&31,hi=lane>>5; const int wid=__builtin_amdgcn_readfirstlane(tid>>6);
  const int q0=qb*QB;
  const bf16*Qw=Qh+(long)(q0+wid*QBLK)*DM;
  const unsigned lds0=(unsigned)(uintptr_t)shm;
  const bf16*ksrc=Kh+(long)lane*DM+wid*8;
  const bf16*vsrc=Vh+(long)(16*(wid&3)+(lane>>2))*DM+(wid>>2)*32+(lane&3)*8;
  const unsigned kdst=lds0+LDS_K+wid*1024, vdst=lds0+LDS_V+wid*1024;
  const int vb0=(int)(lds0+LDS_V)+((lane>>4)&1)*32+(lane&3)*8+(4*hi+((lane&15)>>2))*64;
  typedef __attribute__((address_space(3))) int* lds_iptr;
  const lds_iptr flg=(lds_iptr)((__attribute__((address_space(3))) char*)shm+LDS_WS);
  const int NT=(q0+QB)/KVBLK;
  DMA_K(NT-1,0);DMA_V(NT-1,0);
  bf16x8 qr[4];
  #pragma unroll
  for(int d0=0;d0<4;++d0)qr[d0]=*reinterpret_cast<const bf16x8*>(&Qw[(long)r32*DM+d0*16+hi*8]);
  f32x16 o[2];o[0]=f32x16{};o[1]=f32x16{};
  const int qw0=q0+wid*QBLK, qrow=qw0+r32;
  float carry=1.f; bool done=false; int cur=0;
  for(int t=NT-1;t>=0;--t){
    const int nxt=cur^SLOTB;
    if(t>0){DMA_K(t-1,nxt);DMA_V(t-1,nxt);WAIT_BAR(2);} else {WAIT_BAR(0);}
    const bool active=(64*t<=qw0+30)&&!done;
    if(active){
      f32x16 p0=f32x16{},p1=f32x16{};
      qkt2(p0,p1,(lds_cptr)shm+LDS_K+cur,qr,r32,hi);
      const bool diag=(64*t+63>=qw0);
      float kp[32];
      #pragma unroll
      for(int r=0;r<16;++r){
        #pragma unroll
        for(int p=0;p<2;++p){
          const float z=p?p1[r]:p0[r];
          const float e=__builtin_amdgcn_exp2f(-__builtin_fabsf(z));
          const float ri=__builtin_amdgcn_rcpf(1.0f+e), er=e*ri;
          float bt=(z>=0.f)?ri:er, kv_=(z>=0.f)?er:ri;
          if(diag){ const int kv=64*t+32*p+(r&3)+8*(r>>2)+4*hi; if(kv>=qrow){bt=0.f;kv_=1.f;} }
          kp[16*p+r]=kv_; if(p)p1[r]=bt; else p0[r]=bt;
        }
      }
      float G[8],Go[8];
      #pragma unroll
      for(int u=0;u<8;++u){ const int b=16*(u>>2)+4*(u&3); G[u]=(kp[b]*kp[b+1])*(kp[b+2]*kp[b+3]);
        auto rr=__builtin_amdgcn_permlane32_swap(__float_as_uint(G[u]),__float_as_uint(G[u]),false,false); Go[u]=__uint_as_float(hi?rr[0]:rr[1]); }
      float A=1.f;
      #pragma unroll
      for(int u=7;u>=0;--u){ const int p=u>>2,g=u&3; float run=(carry*A)*(hi?1.f:Go[u]);
        #pragma unroll
        for(int j=3;j>=0;--j){ const int r=4*g+j; const float bt=p?p1[r]:p0[r]; const float w=bt*run; if(p)p1[r]=w; else p0[r]=w; run*=kp[16*p+r]; }
        A*=G[u]*Go[u]; }
      carry*=A;
      u32x4 pw0,pw1,pw2,pw3;
      #define PKW(P,B) cvtpk_s(P[B],P[B+1])
      pw0=(u32x4){PKW(p0,0),PKW(p0,2),PKW(p0,4),PKW(p0,6)};pw1=(u32x4){PKW(p0,8),PKW(p0,10),PKW(p0,12),PKW(p0,14)};pw2=(u32x4){PKW(p1,0),PKW(p1,2),PKW(p1,4),PKW(p1,6)};pw3=(u32x4){PKW(p1,8),PKW(p1,10),PKW(p1,12),PKW(p1,14)};
      SBAR(); pv(o,vb0+cur,PAF(0),PAF(1),PAF(2),PAF(3));
      done=__all(carry<1.17549435e-38f);
    }
    if(lane==0)flg[wid]=done?1:0;
    if(t>0){WAIT_BAR(2);} else {WAIT_BAR(0);}
    const int alld=flg[0]&flg[1]&flg[2]&flg[3]&flg[4]&flg[5]&flg[6]&flg[7];
    cur=nxt;
    if(alld)break;
  }
  asm volatile("s_waitcnt vmcnt(0)":::"memory");
  bf16*Ow=Oh+(long)(q0+wid*QBLK)*DM;
  { bf16*stg=(bf16*)(shm+LDS_OST)+wid*2048;
    #pragma unroll
    for(int r=0;r<16;++r){const int orow=crow(r,hi);
      #pragma unroll
      for(int d0=0;d0<2;++d0)((unsigned short*)stg)[orow*64+d0*32+r32]=(unsigned short)cvtpk_s(o[d0][r],0.f);}
    asm volatile("s_waitcnt lgkmcnt(0)":::"memory");
    #pragma unroll
    for(int i=0;i<4;++i){const int row=i*8+(lane>>3),ch=lane&7; const u32x4 v=*(const u32x4*)(stg+row*64+ch*8); ATTN_STORE16(Ow+(long)row*DM+ch*8,v);} }
  asm volatile("s_waitcnt lgkmcnt(0)\n\ts_barrier":::"memory");
  #undef PKW
  #undef PAF
  #undef DMA_K
  #undef DMA_V
}
#undef SBAR
#undef WAIT_BAR
}
#ifndef EN_P0
#define EN_P0 1
#endif
#ifndef EN_P1
#define EN_P1 1
#endif
#ifndef EN_P2
#define EN_P2 1
#endif
#ifndef EN_P3
#define EN_P3 1
#endif
#ifndef EN_P4
#define EN_P4 1
#endif
#ifndef EN_P5
#define EN_P5 1
#endif
#ifndef EN_P6
#define EN_P6 1
#endif
#ifndef EN_P7
#define EN_P7 1
#endif
#ifndef EN_P8
#define EN_P8 1
#endif
#ifndef EN_P9
#define EN_P9 1
#endif
#ifndef EN_P10
#define EN_P10 1
#endif
#ifndef EN_PF
#define EN_PF 1
#endif
#include <hip/hip_cooperative_groups.h>
namespace cg = cooperative_groups;
constexpr int NWAVES = 8;
constexpr int M = 32768, DMOD = 1024, DFF = 2816, SEQL = 2048, NBATCH = 16, NIN = 7688;
constexpr size_t MiB = 1u << 20;
constexpr size_t WS_CTL = 0, CTL_ZERO_BYTES = 2 * MiB;
constexpr size_t WS_SSQ = 474 * MiB, SSQ_BYTES = (size_t)6 * 32768 * 8;
constexpr size_t WS_NRM = 1 * MiB + 768 * 1024;
constexpr size_t WS_F = 2 * MiB, WS_C2 = 3 * MiB;
constexpr size_t WS_W = 4 * MiB;
constexpr size_t W_13A = 0, W_2A = 11 * MiB, W_IN = W_2A + 5 * MiB + 512 * 1024, W_G = 26 * MiB, W_PROJ = 32 * MiB, W_OUT = 35 * MiB, W_13B = 37 * MiB, W_2B = 48 * MiB;
constexpr size_t WS_HB = 58 * MiB, WS_MB = 122 * MiB, WS_QKV = 186 * MiB, SEG_BYTES = 32 * MiB, WS_END = 476 * MiB;
constexpr size_t SEG_ELEMS = SEG_BYTES / 2;
static_assert(W_IN == 16 * MiB + 512 * 1024 && W_IN + (size_t)4864 * 1024 * 2 == W_G && W_2B + (size_t)1024 * 2816 * 2 <= 54 * MiB, "weight map");
constexpr int NWIN = 4864;
constexpr int RING_BYTES = 131072, MISC_OFF = RING_BYTES, LDS_BYTES = 147456;
static_assert(attn_body::LDS_ATT_TOTAL <= RING_BYTES, "attention scratch fits the ring region");

#ifndef REP_FFN
#define REP_FFN 1
#endif
#ifndef REP_MIX
#define REP_MIX 1
#endif
#ifndef REP_SYNC
#define REP_SYNC 0
#endif
#ifndef REP_ATT
#define REP_ATT 0
#endif
#ifndef REP_P0
#define REP_P0 1
#endif
#define RUN_GEMM(REP, EPI, ORD) do { for (int rp_ = 0; rp_ < (REP); ++rp_) { if (rp_) GSYNC(); pg8::gemm_phase<EPI, ORD, PG8_ALIGN, PG8_SP2>(ldsl, g, S, E); } } while (0)
#define RUN_GEMM_RES(REP) do { for (int rp_ = 0; rp_ < (REP); ++rp_) { pg8::EpiRes E2_ = E; if (rp_ + 1 < (REP)) { E2_.alpha = 0.f; E2_.ssq_next = nullptr; } pg8::gemm_phase<pg8::EpiRes, pg8::StaticOrder, PG8_ALIGN, PG8_SP2>(ldsl, g, S, E2_); if (rp_ + 1 < (REP)) GSYNC(); } } while (0)
#define GAS __attribute__((address_space(1)))
#define LAS __attribute__((address_space(3)))
typedef unsigned short bf16;
typedef unsigned v4u __attribute__((ext_vector_type(4)));
typedef float f32x4 __attribute__((ext_vector_type(4)));
#define LDS_WAIT() asm volatile("s_waitcnt lgkmcnt(0)" ::: "memory")
__device__ __forceinline__ unsigned f2bf(float f) { unsigned u = __builtin_bit_cast(unsigned, f); return (u + 0x7fffu + ((u >> 16) & 1u)) >> 16; }
typedef float fr_f32x2_t __attribute__((ext_vector_type(2))); typedef __bf16 fr_bf16x2_t __attribute__((ext_vector_type(2)));
__device__ __forceinline__ unsigned pk2(float lo, float hi) { const fr_f32x2_t v = {lo, hi}; const fr_bf16x2_t b = __builtin_convertvector(v, fr_bf16x2_t); return __builtin_bit_cast(unsigned, b); }
__device__ __forceinline__ float wave_sum(float v) {
#pragma unroll
    for (int o = 1; o < 64; o <<= 1) v += __shfl_xor(v, o);
    return v;
}
__device__ __forceinline__ void tr_item(const float* W, int Nsrc, int K, int k0, int n0src, int nvalid, bf16* WTrow0, const float* g, LAS float* scr, int lane) {
    const int nl = lane & 31;
#pragma unroll 8
    for (int i = 0; i < 32; ++i) { const int kk = 2 * i + (lane >> 5); float v = 0.f; if (nl < nvalid) { v = ((const GAS float*)W)[(size_t)(k0 + kk) * Nsrc + n0src + nl]; if (g) v *= ((const GAS float*)g)[k0 + kk]; } scr[kk * 33 + nl] = v; }
    LDS_WAIT(); asm volatile("" ::: "memory");
    const int c = lane & 7;
#pragma unroll
    for (int j = 0; j < 4; ++j) { const int n = (lane >> 3) + 8 * j; const LAS float* s = scr + (8 * c) * 33 + n;
        v4u o; o.x = pk2(s[0 * 33], s[1 * 33]); o.y = pk2(s[2 * 33], s[3 * 33]); o.z = pk2(s[4 * 33], s[5 * 33]); o.w = pk2(s[6 * 33], s[7 * 33]);
        *(GAS v4u*)(WTrow0 + (size_t)n * K + k0 + 8 * c) = o; }
    LDS_WAIT(); asm volatile("" ::: "memory");
}

#define XB_TMO      128
#define XB_XCNT(j)  (256  + 64 * (j))
#define XB_XSUB(j)  (1280 + 64 * (j))
#define XB_XGEN(j)  (2304 + 64 * (j))
#define XB_TOP      3328
#define XB_TOPGEN   3392
#define XCD_BAR_WORDS 3456
#define XB_SPIN_CAP (1u << 18)

__device__ __forceinline__ unsigned xb_ld(unsigned* p)              { return __hip_atomic_load(p, __ATOMIC_RELAXED, __HIP_MEMORY_SCOPE_AGENT); }
__device__ __forceinline__ unsigned xb_add(unsigned* p, unsigned v) { return __hip_atomic_fetch_add(p, v, __ATOMIC_RELAXED, __HIP_MEMORY_SCOPE_AGENT); }
__device__ __forceinline__ unsigned xb_xcc_id() { return (unsigned)__builtin_amdgcn_s_getreg((3 << 11) | 20) & 0xFu; }
#define XB_SPIN(cond, bar) do { unsigned _sp = 0; while (cond) { __builtin_amdgcn_s_sleep(1); \
    if ((++_sp & 255u) == 0u) { if (xb_ld(&(bar)[XB_TMO])) break; if (_sp > XB_SPIN_CAP) { atomicAdd(&(bar)[XB_TMO], 1u); break; } } } } while (0)

struct XcdBarrier {
    unsigned* bar; unsigned x;
    volatile LAS unsigned* st;
};

__device__ __forceinline__ XcdBarrier xcd_barrier_post(unsigned* bar, volatile LAS unsigned* st) {
    XcdBarrier b; b.bar = bar; b.x = xb_xcc_id(); b.st = st;
    if (threadIdx.x == 0) (void)xb_add(&bar[XB_XCNT(b.x)], 1u);
    return b;
}
__device__ __forceinline__ void xcd_barrier_complete(unsigned* bar, unsigned x, unsigned& nloc, unsigned& nx) {
    const unsigned G = gridDim.x * gridDim.y * gridDim.z;
    unsigned sum, cnt, mine, sp = 0u;
    for (;;) {
        sum = 0u; cnt = 0u; mine = 0u;
#pragma unroll
        for (unsigned j = 0; j < 16; ++j) { const unsigned c = xb_ld(&bar[XB_XCNT(j)]); sum += c; cnt += (c > 0u) ? 1u : 0u; mine = (j == x) ? c : mine; }
        if (sum == G) break;
        __builtin_amdgcn_s_sleep(1);
        if ((++sp & 255u) == 0u) { if (xb_ld(&bar[XB_TMO])) break; if (sp > XB_SPIN_CAP) { atomicAdd(&bar[XB_TMO], 1u); break; } }
    }
    nloc = mine > 0u ? mine : 1u; nx = cnt > 0u ? cnt : 1u;
}

__device__ __forceinline__ void xcd_barrier(const XcdBarrier& b) {
    asm volatile("s_waitcnt vmcnt(0)" ::: "memory");
    __syncthreads();
    if (threadIdx.x == 0) {
        unsigned* bar = b.bar;
        __builtin_amdgcn_s_waitcnt(0);
        unsigned nloc = b.st[0], nx = b.st[1];
        if (nloc == 0u) { xcd_barrier_complete(bar, b.x, nloc, nx); b.st[0] = nloc; b.st[1] = nx; }
        const unsigned old = xb_add(&bar[XB_XSUB(b.x)], 1u);
        const unsigned gen = old / nloc;
        if (old + 1u == (gen + 1u) * nloc) {
            __builtin_amdgcn_fence(__ATOMIC_RELEASE, "agent");
            asm volatile("s_waitcnt vmcnt(0)" ::: "memory");
            const unsigned og = xb_add(&bar[XB_TOP], 1u);
            const unsigned tg = og / nx;
            if (og + 1u == (tg + 1u) * nx) xb_add(&bar[XB_TOPGEN], 1u);
            else XB_SPIN(xb_ld(&bar[XB_TOPGEN]) == tg, bar);
            __builtin_amdgcn_fence(__ATOMIC_ACQUIRE, "agent");
            xb_add(&bar[XB_XGEN(b.x)], 1u);
            asm volatile("s_waitcnt vmcnt(0)" ::: "memory");
        } else {
            XB_SPIN(xb_ld(&bar[XB_XGEN(b.x)]) == gen, bar);
            __builtin_amdgcn_fence(__ATOMIC_ACQUIRE, "agent");
            asm volatile("s_waitcnt vmcnt(0)" ::: "memory");
        }
    }
    __syncthreads();
}

constexpr int CW_BAR = 4096;
struct Args { const float* in[22]; float* out; unsigned char* ws; };

__global__ void __launch_bounds__(NWAVES * 64, 2) mk_fwd(Args args) {
    extern __shared__ __attribute__((aligned(16))) unsigned char lds[];
    cg::grid_group grid = cg::this_grid();
    { LAS unsigned* mz = (LAS unsigned*)((LAS unsigned char*)lds + MISC_OFF); if (threadIdx.x < 64) mz[threadIdx.x] = 0u; __syncthreads(); }
    XcdBarrier bar = xcd_barrier_post((unsigned*)(args.ws + WS_CTL) + CW_BAR, (volatile LAS unsigned*)((LAS unsigned char*)lds + MISC_OFF) + 8);
#define GSYNC() do { if (__builtin_expect(args.ws == nullptr, 0)) grid.sync(); else xcd_barrier(bar); } while (0)
#define ENV \
    int tid_e = threadIdx.x; asm volatile("" : "+v"(tid_e)); const int tid = tid_e, lane = tid & 63, wave = __builtin_amdgcn_readfirstlane(tid >> 6); (void)lane; \
    int G = gridDim.x, bx = blockIdx.x; asm volatile("" : "+s"(G), "+s"(bx)); const int gw = bx * NWAVES + wave, NGW = G * NWAVES; (void)gw; (void)NGW; \
    unsigned char* ws = args.ws; asm volatile("" : "+s"(ws)); int l = l_it; asm volatile("" : "+s"(l)); \
    LAS unsigned char* ldsl = (LAS unsigned char*)lds; (void)ldsl; LAS float* scr = (LAS float*)(ldsl + wave * 16384); (void)scr; \
    volatile LAS int* MISC = (volatile LAS int*)(ldsl + MISC_OFF); (void)MISC; unsigned* ctl = (unsigned*)(ws + WS_CTL); (void)ctl; \
    pg8::ssq_t* ssqb = (pg8::ssq_t*)(ws + WS_SSQ); float* Fb = (float*)(ws + WS_F); float* C2b = (float*)(ws + WS_C2); bf16* Wb = (bf16*)(ws + WS_W); \
    bf16* HB = (bf16*)(ws + WS_HB); bf16* MB = (bf16*)(ws + WS_MB); bf16* QKV = (bf16*)(ws + WS_QKV); bf16* HFF = QKV; \
    const float* x = args.in[0]; float* out = args.out; \
    pg8::ssq_t* ssq0 = ssqb + (size_t)(3 * l) * M; pg8::ssq_t* ssq1 = ssq0 + M; pg8::ssq_t* ssq2 = ssq1 + M; pg8::ssq_t* ssq3 = (l == 0) ? (ssq2 + M) : nullptr; \
    (void)Fb; (void)C2b; (void)Wb; (void)HB; (void)MB; (void)HFF; (void)x; (void)out; (void)ssq0; (void)ssq1; (void)ssq2; (void)ssq3;
#pragma nounroll
    for (int l_it = 0; l_it < 2; ++l_it) {
#if EN_P0
        for (int rp0_ = 0; rp0_ < REP_P0; ++rp0_) {
            ENV
            const float* n1 = args.in[1] + l * 1024; const float* w1a = args.in[2] + (size_t)l * 1024 * DFF; const float* w3a = args.in[3] + (size_t)l * 1024 * DFF; const float* w2a = args.in[4] + (size_t)l * DFF * 1024;
            const float* nm = args.in[5] + l * 1024; const float* win = args.in[6] + (size_t)l * 1024 * NIN;
            const float* pa = args.in[13] + (size_t)l * 512 * 1024; const float* pb = args.in[14] + (size_t)l * 512 * 1024; const float* pc = args.in[15] + (size_t)l * 512 * 1024;
            const float* wo = args.in[16] + (size_t)l * 1024 * 1024; const float* n2 = args.in[17] + l * 1024;
            const float* w1b = args.in[18] + (size_t)l * 1024 * DFF; const float* w3b = args.in[19] + (size_t)l * 1024 * DFF; const float* w2b = args.in[20] + (size_t)l * DFF * 1024;
            constexpr int I13 = 16 * 176, I2 = 44 * 32, IIN = 16 * 152, IG = 16 * 96, IP = 8 * 32, IO = 16 * 32;
            constexpr int NITEMS = 2 * I13 + 2 * I2 + IIN + IG + 3 * IP + IO;
            for (int it = gw; it < NITEMS; it += NGW) {
                int r = it;
                if (r < 2 * I13) { const bool second = r >= I13; if (second) r -= I13; const int kb = r / 176, j = r % 176, tile = j >> 3, sub = j & 7;
                    const float* src = second ? (sub < 4 ? w1b : w3b) : (sub < 4 ? w1a : w3a);
                    tr_item(src, DFF, 1024, 64 * kb, 128 * tile + 32 * (sub & 3), 32, (bf16*)((unsigned char*)Wb + (second ? W_13B : W_13A)) + (size_t)(32 * j) * 1024, second ? n2 : n1, scr, lane); continue; }
                r -= 2 * I13;
                if (r < 2 * I2) { const bool second = r >= I2; if (second) r -= I2; const int kb = r / 32, j = r % 32;
                    tr_item(second ? w2b : w2a, 1024, DFF, 64 * kb, 32 * j, 32, (bf16*)((unsigned char*)Wb + (second ? W_2B : W_2A)) + (size_t)(32 * j) * DFF, nullptr, scr, lane); continue; }
                r -= 2 * I2;
                if (r < IIN) { const int kb = r / 152, j = r % 152, row0 = 32 * j; int src0, nv;
                    if (row0 < 3072) { src0 = row0; nv = 32; } else if (row0 < 4608) { src0 = row0 + 8; nv = 32; } else if (row0 == 4608) { src0 = 3072; nv = 8; } else { src0 = 0; nv = 0; }
                    tr_item(win, NIN, 1024, 64 * kb, src0, nv, (bf16*)((unsigned char*)Wb + W_IN) + (size_t)row0 * 1024, nm, scr, lane); continue; }
                r -= IIN;
                if (r < IG) { const int kb = r / 96, j = r % 96;
                    tr_item(win, NIN, 1024, 64 * kb, 4616 + 32 * j, 32, (bf16*)((unsigned char*)Wb + W_G) + (size_t)(32 * j) * 1024, nm, scr, lane); continue; }
                r -= IG;
                if (r < 3 * IP) { const int br = r / IP; r -= br * IP; const int kb = r / 32, j = r % 32; const float* src = br == 0 ? pa : (br == 1 ? pb : pc);
                    tr_item(src, 1024, 512, 64 * kb, 32 * j, 32, (bf16*)((unsigned char*)Wb + W_PROJ) + (size_t)(br * 1024 + 32 * j) * 512, nullptr, scr, lane); continue; }
                r -= 3 * IP;
                { const int kb = r / 32, j = r % 32;
                    tr_item(wo, 1024, 1024, 64 * kb, 32 * j, 32, (bf16*)((unsigned char*)Wb + W_OUT) + (size_t)(32 * j) * 1024, nullptr, scr, lane); }
            }
            if (l == 0) {
                for (int m = gw; m < M; m += NGW) {
                    const GAS f32x4* xr = (const GAS f32x4*)(x + (size_t)m * 1024) + lane; f32x4 v[4]; float s = 0.f;
#pragma unroll
                    for (int j = 0; j < 4; ++j) { v[j] = xr[64 * j]; s += (v[j].x * v[j].x + v[j].y * v[j].y) + (v[j].z * v[j].z + v[j].w * v[j].w); }
                    s = wave_sum(s);
                    GAS unsigned long long* o8 = (GAS unsigned long long*)(HB + (size_t)m * 1024) + lane;
#pragma unroll
                    for (int j = 0; j < 4; ++j) o8[64 * j] = (unsigned long long)pk2(v[j].x, v[j].y) | ((unsigned long long)pk2(v[j].z, v[j].w) << 32);
                    if (lane == 0) ssqb[m] = (pg8::ssq_t)(s * pg8::SSQ_SCALE);
                }
            }
        }
#endif
        GSYNC();
#if EN_P1
        { ENV
        { pg8::Gemm g{HB, (const bf16*)((unsigned char*)Wb + W_13A), M, 2 * DFF, 1024}; pg8::StaticOrder S; S.init(M, 2 * DFF, G, bx);
          pg8::EpiSwiGLU E{HFF, DFF, ssq0}; RUN_GEMM(REP_FFN, pg8::EpiSwiGLU, pg8::StaticOrder); }
        }
#endif
        GSYNC();
#if EN_P2
        { ENV
        { pg8::Gemm g{HFF, (const bf16*)((unsigned char*)Wb + W_2A), M, 1024, DFF}; pg8::StaticOrder S; S.init(M, 1024, G, bx);
          pg8::EpiRes E{HB, ssq1, 0.5f}; RUN_GEMM_RES(REP_FFN); }
        }
#endif
        GSYNC();
#if EN_P3
        { ENV
        { pg8::Gemm g{HB, (const bf16*)((unsigned char*)Wb + W_IN), M, NWIN, 1024}; pg8::StaticOrder S; S.init(M, NWIN, G, bx);
          pg8::EpiQKV E{QKV, Fb, ssq1, SEG_ELEMS}; RUN_GEMM(REP_MIX, pg8::EpiQKV, pg8::StaticOrder); }
        }
#endif
        GSYNC();
#if EN_P4
        { ENV
        if (gw < NBATCH * 8) {
            const int b = gw >> 3, h = gw & 7; const float fb = args.in[7][l * 8 + h];
            float v[32]; float run = 0.f;
#pragma unroll
            for (int i = 0; i < 32; ++i) { const float xx = ((const GAS float*)Fb)[((size_t)b * SEQL + lane * 32 + i) * 8 + h] + fb;
                const float e = __builtin_amdgcn_exp2f(-__builtin_fabsf(xx) * pg8::LOG2E); const float ls2 = __builtin_fminf(xx, 0.f) * pg8::LOG2E - __builtin_amdgcn_logf(1.0f + e);
                run += ls2; v[i] = run; }
            float inc = run;
#pragma unroll
            for (int d = 1; d < 64; d <<= 1) { const float t = __shfl_up(inc, d); if (lane >= d) inc += t; }
            const float pre = inc - run;
            float* dst = C2b + ((size_t)b * 8 + h) * SEQL + lane * 32;
#pragma unroll
            for (int i = 0; i < 32; ++i) dst[i] = -(pre + v[i]);
        }
        { float* NRM = (float*)(ws + WS_NRM);
          for (int it = gw; it < 16384; it += NGW) { const int sg = it >> 12, rem = it & 4095, b = rem >> 8, hd = (rem >> 5) & 7, tl = rem & 31;
            if (sg < 2 && hd >= 2) continue;
            const int qseg = (sg == 0) ? 0 : (sg == 1) ? 1 : (sg == 2) ? 3 : 4;
            const GAS v4u* src = (const GAS v4u*)(QKV + (size_t)qseg * SEG_ELEMS + ((size_t)b * SEQL + tl * 64 + lane) * 512 + hd * 64); float ss = 0.f;
#pragma unroll
            for (int j = 0; j < 8; ++j) { const v4u w = src[j]; const float a0 = pg8::bf_lo(w.x), a1 = pg8::bf_hi(w.x), a2 = pg8::bf_lo(w.y), a3 = pg8::bf_hi(w.y), a4 = pg8::bf_lo(w.z), a5 = pg8::bf_hi(w.z), a6 = pg8::bf_lo(w.w), a7 = pg8::bf_hi(w.w);
                ss += (a0 * a0 + a1 * a1) + (a2 * a2 + a3 * a3) + ((a4 * a4 + a5 * a5) + (a6 * a6 + a7 * a7)); }
#pragma unroll
            for (int o = 1; o < 64; o <<= 1) ss = __builtin_fmaxf(ss, __shfl_xor(ss, o));
            if (lane == 0) NRM[it] = ss; } }
        }
#endif
        GSYNC();
#if EN_P5
        {
            ENV
            using abf = attn_body::bf16;
            for (;;) {
                if (tid == 0) MISC[0] = (int)atomicAdd(ctl + l, 1u);
                __syncthreads(); const int it = MISC[0]; __syncthreads();
                if (it >= 4096) break;
                if (it < 3072) { const int qb = 7 - it / 384, rem = it % 384, b = rem / 24, vh = rem % 24; const size_t rb = (size_t)b * SEQL * 512;
                    const float* NRM = (const float*)(ws + WS_NRM); int t0 = 0;
                    if (vh < 4 || vh >= 16) { const int sq = (vh < 16) ? 0 : 2, hd = (vh < 16) ? ((vh >> 1) & 1) : (vh - 16); const int tt = lane & 31;
                        const float* nq = NRM + (((size_t)sq * 16 + b) * 8 + hd) * 32 + 4 * qb; const float* nk = NRM + (((size_t)(sq + 1) * 16 + b) * 8 + hd) * 32;
                        const float qn2 = __builtin_fmaxf(__builtin_fmaxf(nq[0], nq[1]), __builtin_fmaxf(nq[2], nq[3])); const float kn2 = nk[tt];
                        float bd; if (vh < 16) bd = 0.25f * pg8::LOG2E * (float)(64 * tt + 63 - 256 * qb); else { const float* ct = C2b + ((size_t)b * 8 + (vh - 16)) * SEQL; bd = ct[64 * tt + 63] - ct[256 * qb]; }
                        const bool keep = (tt >= 4 * qb) || !(sqrtf(qn2 * kn2) + bd < -150.f);
                        const unsigned long long km = __ballot(keep); t0 = __builtin_amdgcn_readfirstlane((int)__builtin_ctzll(km)) & ~1; }
                    if (vh < 16) { const int h = vh >> 2, c = (vh >> 1) & 1, e = vh & 1; const float sl2 = __builtin_amdgcn_exp2f(-2.0f * (float)(h + 1)) * pg8::LOG2E;
                        attn_body::attn_unit<8, 0>(qb, t0, (const abf*)(QKV + 0 * SEG_ELEMS + rb + h * 128 + c * 64), (const abf*)(QKV + 1 * SEG_ELEMS + rb + h * 128 + c * 64), (const abf*)(QKV + 2 * SEG_ELEMS + rb + h * 128 + e * 64),
                                                   (abf*)(MB + (size_t)c * SEG_ELEMS + rb + h * 128 + e * 64), sl2, nullptr, (char*)lds);
                    } else { const int h = vh - 16;
                        attn_body::attn_unit<8, 1>(qb, t0, (const abf*)(QKV + 3 * SEG_ELEMS + rb + h * 64), (const abf*)(QKV + 4 * SEG_ELEMS + rb + h * 64), (const abf*)(QKV + 5 * SEG_ELEMS + rb + h * 64),
                                                   (abf*)(QKV + 3 * SEG_ELEMS + rb + h * 64), 0.f, C2b + ((size_t)b * 8 + h) * SEQL, (char*)lds); }
                } else { const int i2 = it - 3072, qb = 7 - i2 / 128, rem = i2 % 128, b = rem >> 3, h = rem & 7; const size_t rb = (size_t)b * SEQL * 512;
                    attn_body::sb_unit(qb, (const abf*)(QKV + 6 * SEG_ELEMS + rb + h * 64), (const abf*)(QKV + 7 * SEG_ELEMS + rb + h * 64), (const abf*)(QKV + 8 * SEG_ELEMS + rb + h * 64), (abf*)(QKV + 6 * SEG_ELEMS + rb + h * 64), (char*)lds); }
            }
        }
#endif
        GSYNC();
#if EN_P6
        for (int rs_ = 0; rs_ < REP_SYNC; ++rs_) GSYNC();
#if REP_ATT
        { ENV
            using abf = attn_body::bf16;
            for (;;) {
                if (tid == 0) MISC[0] = (int)atomicAdd(ctl + 8 + l, 1u);
                __syncthreads(); const int it = MISC[0]; __syncthreads();
                if (it >= 2048) break;
                const int qb = 7 - it / 256, rem = it % 256, b = rem / 16, vh = rem % 16; const size_t rb = (size_t)b * SEQL * 512;
                const int h = vh >> 2, c = (vh >> 1) & 1, e = vh & 1; const float sl2 = __builtin_amdgcn_exp2f(-2.0f * (float)(h + 1)) * pg8::LOG2E;
                attn_body::attn_unit<8, 0>(qb, 0, (const abf*)(QKV + 0 * SEG_ELEMS + rb + h * 128 + c * 64), (const abf*)(QKV + 1 * SEG_ELEMS + rb + h * 128 + c * 64), (const abf*)(QKV + 2 * SEG_ELEMS + rb + h * 128 + e * 64),
                                           (abf*)(MB + (size_t)c * SEG_ELEMS + rb + h * 128 + e * 64), sl2, nullptr, (char*)lds);
            }
        }
        GSYNC();
#endif
        { ENV
        { pg8::Gemm g{HB, (const bf16*)((unsigned char*)Wb + W_G), M, 3072, 1024}; pg8::StaticOrder S; S.init(M, 3072, G, bx);
          pg8::EpiGate E{QKV, ssq1, SEG_ELEMS}; RUN_GEMM(REP_MIX, pg8::EpiGate, pg8::StaticOrder); }
        {
            const float lam_init = (l == 0) ? 0.2f : (0.8f - 0.6f * 0.7408182206817179f);
            const float s1 = wave_sum(args.in[8][l * 64 + lane] * args.in[9][l * 64 + lane]), s2 = wave_sum(args.in[10][l * 64 + lane] * args.in[11][l * 64 + lane]);
            const float lam = __expf(s1) - __expf(s2) + lam_init;
            const float* sg = args.in[12] + l * 128 + (lane & 15) * 8; float gs[8];
#pragma unroll
            for (int i = 0; i < 8; ++i) gs[i] = sg[i] * (1.0f - lam_init);
            for (int m = gw; m < M; m += NGW) {
                const v4u a = *(const GAS v4u*)(MB + (size_t)m * 512 + lane * 8), bq = *(const GAS v4u*)(MB + SEG_ELEMS + (size_t)m * 512 + lane * 8);
                float v[8];
                v[0] = pg8::bf_lo(a.x) - lam * pg8::bf_lo(bq.x); v[1] = pg8::bf_hi(a.x) - lam * pg8::bf_hi(bq.x); v[2] = pg8::bf_lo(a.y) - lam * pg8::bf_lo(bq.y); v[3] = pg8::bf_hi(a.y) - lam * pg8::bf_hi(bq.y);
                v[4] = pg8::bf_lo(a.z) - lam * pg8::bf_lo(bq.z); v[5] = pg8::bf_hi(a.z) - lam * pg8::bf_hi(bq.z); v[6] = pg8::bf_lo(a.w) - lam * pg8::bf_lo(bq.w); v[7] = pg8::bf_hi(a.w) - lam * pg8::bf_hi(bq.w);
                float s = 0.f;
#pragma unroll
                for (int i = 0; i < 8; ++i) s += v[i] * v[i];
                s += __shfl_xor(s, 1); s += __shfl_xor(s, 2); s += __shfl_xor(s, 4); s += __shfl_xor(s, 8);
                const float rs = 1.0f / sqrtf(s * (1.0f / 128.0f) + 1e-5f);
                v4u o; o.x = pk2(v[0] * rs * gs[0], v[1] * rs * gs[1]); o.y = pk2(v[2] * rs * gs[2], v[3] * rs * gs[3]); o.z = pk2(v[4] * rs * gs[4], v[5] * rs * gs[5]); o.w = pk2(v[6] * rs * gs[6], v[7] * rs * gs[7]);
                *(GAS v4u*)(QKV + (size_t)m * 512 + lane * 8) = o;
            }
        }
        }
#endif
        GSYNC();
#if EN_P7
        { ENV
        { pg8::Gemm g{QKV, (const bf16*)((unsigned char*)Wb + W_PROJ), M, 1024, 512}; pg8::ProjOrder S{G, bx};
          pg8::EpiProj E{QKV, MB, SEG_ELEMS}; RUN_GEMM(REP_MIX, pg8::EpiProj, pg8::ProjOrder); }
        }
#endif
        GSYNC();
#if EN_P8
        { ENV
        { pg8::Gemm g{MB, (const bf16*)((unsigned char*)Wb + W_OUT), M, 1024, 1024}; pg8::StaticOrder S; S.init(M, 1024, G, bx);
          pg8::EpiRes E{HB, ssq2, 1.0f}; RUN_GEMM_RES(REP_MIX); }
        }
#endif
        GSYNC();
#if EN_P9
        { ENV
        { pg8::Gemm g{HB, (const bf16*)((unsigned char*)Wb + W_13B), M, 2 * DFF, 1024}; pg8::StaticOrder S; S.init(M, 2 * DFF, G, bx);
          pg8::EpiSwiGLU E{HFF, DFF, ssq2}; RUN_GEMM(REP_FFN, pg8::EpiSwiGLU, pg8::StaticOrder); }
        }
#endif
        GSYNC();
#if EN_P10
        { ENV
        { pg8::Gemm g{HFF, (const bf16*)((unsigned char*)Wb + W_2B), M, 1024, DFF}; pg8::StaticOrder S; S.init(M, 1024, G, bx);
          pg8::EpiRes E{HB, ssq3, 0.5f}; RUN_GEMM_RES(REP_FFN); }
        }
#endif
        GSYNC();
    }
#if EN_PF
    {
        const int l_it = 0; ENV
        const GAS f32x4* gn = (const GAS f32x4*)args.in[21]; const f32x4 g0 = gn[2 * lane], g1 = gn[2 * lane + 1], g2 = gn[128 + 2 * lane], g3 = gn[129 + 2 * lane];
        for (int m = gw; m < M; m += NGW) {
            const GAS v4u* hr = (const GAS v4u*)(HB + (size_t)m * 1024); const v4u a = hr[lane], bq = hr[64 + lane];
            const f32x4 v0 = {pg8::bf_lo(a.x), pg8::bf_hi(a.x), pg8::bf_lo(a.y), pg8::bf_hi(a.y)}, v1 = {pg8::bf_lo(a.z), pg8::bf_hi(a.z), pg8::bf_lo(a.w), pg8::bf_hi(a.w)};
            const f32x4 v2 = {pg8::bf_lo(bq.x), pg8::bf_hi(bq.x), pg8::bf_lo(bq.y), pg8::bf_hi(bq.y)}, v3 = {pg8::bf_lo(bq.z), pg8::bf_hi(bq.z), pg8::bf_lo(bq.w), pg8::bf_hi(bq.w)};
            float s = ((v0.x * v0.x + v0.y * v0.y) + (v0.z * v0.z + v0.w * v0.w)) + ((v1.x * v1.x + v1.y * v1.y) + (v1.z * v1.z + v1.w * v1.w));
            s += ((v2.x * v2.x + v2.y * v2.y) + (v2.z * v2.z + v2.w * v2.w)) + ((v3.x * v3.x + v3.y * v3.y) + (v3.z * v3.z + v3.w * v3.w));
            const float rs = 1.0f / sqrtf(wave_sum(s) * (1.0f / 1024.0f) + 1e-6f);
            GAS f32x4* o = (GAS f32x4*)(out + (size_t)m * 1024);
            o[2 * lane] = v0 * rs * g0; o[2 * lane + 1] = v1 * rs * g1; o[128 + 2 * lane] = v2 * rs * g2; o[129 + 2 * lane] = v3 * rs * g3;
        }
    }
#endif
}

extern "C" void kernel_launch(void* const* d_in, const int* in_sizes, int n_in, void* d_out, int out_size, void* d_ws, size_t ws_size, hipStream_t stream) {
    static int grid = 0;
    if (grid == 0) {
        if (n_in != 22 || in_sizes[0] != M * DMOD || out_size != M * DMOD || ws_size < WS_END) { fprintf(stderr, "kernel_launch: unexpected shapes (n_in %d, ws %zu)\n", n_in, ws_size); grid = -1; return; }
        int dev = 0, cus = 0, per_cu = 0;
        if (hipGetDevice(&dev) != hipSuccess || hipDeviceGetAttribute(&cus, hipDeviceAttributeMultiprocessorCount, dev) != hipSuccess) { grid = -1; return; }
        if (hipFuncSetAttribute((const void*)mk_fwd, hipFuncAttributeMaxDynamicSharedMemorySize, LDS_BYTES) != hipSuccess) { fprintf(stderr, "kernel_launch: hipFuncSetAttribute failed\n"); grid = -1; return; }
        if (hipOccupancyMaxActiveBlocksPerMultiprocessor(&per_cu, (const void*)mk_fwd, NWAVES * 64, LDS_BYTES) != hipSuccess || per_cu < 1) { fprintf(stderr, "kernel_launch: occupancy query says %d\n", per_cu); per_cu = 1; }
        (void)hipGetLastError();
        grid = cus * 1;
        fprintf(stderr, "kernel_launch: grid %d (occupancy query %d per CU)\n", grid, per_cu);
    }
    if (grid < 0) return;
    (void)hipMemsetAsync((char*)d_ws + WS_CTL, 0, CTL_ZERO_BYTES, stream);
    (void)hipMemsetAsync((char*)d_ws + WS_SSQ, 0, SSQ_BYTES, stream);
    Args a{};
    for (int i = 0; i < 22; ++i) a.in[i] = (const float*)d_in[i];
    a.out = (float*)d_out; a.ws = (unsigned char*)d_ws;
    void* kargs[] = {&a};
    hipError_t e = hipLaunchCooperativeKernel((const void*)mk_fwd, dim3(grid), dim3(NWAVES * 64), kargs, LDS_BYTES, stream);
    if (e != hipSuccess) fprintf(stderr, "kernel_launch: cooperative launch failed: %s\n", hipGetErrorString(e));
}
```

```cpp
#include <hip/hip_runtime.h>
#include <cstdio>
#include <cstdint>
namespace pg8 {
#define PG8_LAS __attribute__((address_space(3)))
typedef unsigned short bf16_t;
typedef short bf16x8 __attribute__((ext_vector_type(8)));
typedef float f32x4 __attribute__((ext_vector_type(4)));
typedef unsigned u32x4 __attribute__((ext_vector_type(4)));
constexpr int BM = 256, BK = 64, HALF = 128, HTB = HALF * BK * 2  , STAGE_BYTES = 8 * HTB, NXCD = 8, WGM = 8;

__host__ __device__ __forceinline__ int lds_byte(int r, int c) { const int st = (r >> 4) * 2 + (c >> 5), rr = r & 15, cc = c & 31, ob = rr * 64 + cc * 2; return st * 1024 + (ob ^ (((ob >> 9) & 1) << 5)); }
__host__ __device__ __forceinline__ void stage_rc(int b, int& R, int& C) { const int st = b / 1024, sb = b % 1024, swz = sb ^ (((sb >> 9) & 1) << 5); R = (st >> 1) * 16 + swz / 64; C = (st & 1) * 32 + (swz % 64) / 2; }
__host__ __device__ __forceinline__ int perm32(int rho) { const int n = rho >> 4, i = rho & 15; return 8 * (i >> 2) + 4 * n + (i & 3); }

struct Unit { int pm, pn; };
struct Gemm { const bf16_t* A; const bf16_t* Bt; int M, N, K; };

struct StaticOrder {
    int nM, nN, nwg, G, c;
    __host__ __device__ void init(int M, int N, int G_, int c_) { nM = M / BM; nN = N / BM; nwg = nM * nN; G = G_; c = c_; }
    __host__ __device__ bool next(int i, Unit& u) const {
        const long L = (long)i * G + c; if (L >= nwg) return false;
        int wgid = (int)L; { const int q = nwg / NXCD, r = nwg % NXCD, xcd = wgid % NXCD, off = wgid / NXCD; wgid = (xcd < r ? xcd * (q + 1) : r * (q + 1) + (xcd - r) * q) + off; }
        const int nig = WGM * nN, gid = wgid / nig, fm = gid * WGM, gsz = (nM - fm) < WGM ? (nM - fm) : WGM;
        u.pm = fm + ((wgid % nig) % gsz); u.pn = (wgid % nig) / gsz; return true;
    }
    __device__ __forceinline__ void a_ready(const Unit&) const {}
    __device__ __forceinline__ void done(const Unit&) const {}
};

typedef float pk_f32x2_t __attribute__((ext_vector_type(2))); typedef __bf16 pk_bf16x2_t __attribute__((ext_vector_type(2)));
__device__ __forceinline__ unsigned cvt_pk_bf16(float lo, float hi) { const pk_f32x2_t v = {lo, hi}; const pk_bf16x2_t b = __builtin_convertvector(v, pk_bf16x2_t); return __builtin_bit_cast(unsigned, b); }
typedef float f32x2 __attribute__((ext_vector_type(2)));
typedef unsigned u32x2 __attribute__((ext_vector_type(2)));
constexpr float LOG2E = 1.4426950408889634f;
typedef unsigned long long ssq_t;
constexpr float SSQ_SCALE = 16777216.0f;
#define PG8_GAS __attribute__((address_space(1)))
__device__ __forceinline__ float rstd_of(const ssq_t* ssq, int row) { return __builtin_amdgcn_rsqf((float)((const PG8_GAS ssq_t*)ssq)[row] * (1.0f / (SSQ_SCALE * 1024.0f)) + 1e-6f); }
__device__ __forceinline__ void rstd8(const ssq_t* ssq, int row0, float scale, float (&rsv)[2][4]) {
    ssq_t raw[2][4];
#pragma unroll
    for (int ai = 0; ai < 2; ++ai)
#pragma unroll
        for (int m = 0; m < 4; ++m) raw[ai][m] = ((const PG8_GAS ssq_t*)ssq)[row0 + ai * HALF + m * 16];
#pragma unroll
    for (int ai = 0; ai < 2; ++ai)
#pragma unroll
        for (int m = 0; m < 4; ++m) asm volatile("" : "+v"(raw[ai][m]));
#pragma unroll
    for (int ai = 0; ai < 2; ++ai)
#pragma unroll
        for (int m = 0; m < 4; ++m) rsv[ai][m] = __builtin_amdgcn_rsqf((float)raw[ai][m] * (1.0f / (SSQ_SCALE * 1024.0f)) + 1e-6f) * scale;
}
__device__ __forceinline__ float bf_lo(unsigned w) { return __uint_as_float(w << 16); }
__device__ __forceinline__ float bf_hi(unsigned w) { return __uint_as_float(w & 0xffff0000u); }

struct EpiSwiGLU {
    static constexpr bool PERM = true, AFTER_DRAIN = false;
    bf16_t* O; int ldc; const ssq_t* ssq;
    __device__ __forceinline__ void operator()(const f32x4 (&acc)[2][2][4][2], const Unit& u, int wr, int wc, int fr, int fq) const {
        const int row0 = u.pm * BM + wr * 64 + fr, col0 = u.pn * HALF + wc * 32 + 8 * fq;
        float rsv[2][4];
        rstd8(ssq, row0, 1.0f, rsv);
#pragma unroll
        for (int ai = 0; ai < 2; ++ai)
#pragma unroll
            for (int m = 0; m < 4; ++m) { const int row = row0 + ai * HALF + m * 16; const float rs = rsv[ai][m], rsn = rs * -LOG2E, rs2 = rs * rs;
                float h[8];
#pragma unroll
                for (int n = 0; n < 2; ++n)
#pragma unroll
                    for (int j = 0; j < 4; ++j) { const float a = acc[ai][0][m][n][j], bq = acc[ai][1][m][n][j];
                        h[4 * n + j] = ((a * bq) * rs2) * __builtin_amdgcn_rcpf(1.0f + __builtin_amdgcn_exp2f(a * rsn)); }
                u32x4 w; w.x = cvt_pk_bf16(h[0], h[1]); w.y = cvt_pk_bf16(h[2], h[3]); w.z = cvt_pk_bf16(h[4], h[5]); w.w = cvt_pk_bf16(h[6], h[7]);
                *(PG8_GAS u32x4*)(O + (size_t)row * ldc + col0) = w; }
    }
};
struct EpiRes {
    static constexpr bool PERM = true, AFTER_DRAIN = false;
    bf16_t* hb; ssq_t* ssq_next; float alpha;
    __device__ __forceinline__ void operator()(const f32x4 (&acc)[2][2][4][2], const Unit& u, int wr, int wc, int fr, int fq) const {
        const int row0 = u.pm * BM + wr * 64 + fr, col0 = u.pn * BM + wc * 32 + 8 * fq;
#pragma unroll
        for (int ai = 0; ai < 2; ++ai) {
            u32x4 pre[4][2];
#pragma unroll
            for (int m = 0; m < 4; ++m)
#pragma unroll
                for (int bj = 0; bj < 2; ++bj) pre[m][bj] = *(const PG8_GAS u32x4*)(hb + (size_t)(row0 + ai * HALF + m * 16) * 1024 + col0 + bj * HALF);
#pragma unroll
            for (int m = 0; m < 4; ++m) { const int row = row0 + ai * HALF + m * 16; float s = 0.f;
#pragma unroll
                for (int bj = 0; bj < 2; ++bj) { const u32x4 old = pre[m][bj]; const f32x4 a0 = acc[ai][bj][m][0], a1 = acc[ai][bj][m][1];
                    const float h0 = bf_lo(old.x) + alpha * a0[0], h1 = bf_hi(old.x) + alpha * a0[1], h2 = bf_lo(old.y) + alpha * a0[2], h3 = bf_hi(old.y) + alpha * a0[3];
                    const float h4 = bf_lo(old.z) + alpha * a1[0], h5 = bf_hi(old.z) + alpha * a1[1], h6 = bf_lo(old.w) + alpha * a1[2], h7 = bf_hi(old.w) + alpha * a1[3];
                    s += ((h0 * h0 + h1 * h1) + (h2 * h2 + h3 * h3)) + ((h4 * h4 + h5 * h5) + (h6 * h6 + h7 * h7));
                    u32x4 w; w.x = cvt_pk_bf16(h0, h1); w.y = cvt_pk_bf16(h2, h3); w.z = cvt_pk_bf16(h4, h5); w.w = cvt_pk_bf16(h6, h7);
                    *(PG8_GAS u32x4*)(hb + (size_t)row * 1024 + col0 + bj * HALF) = w; }
                s += __shfl_xor(s, 16); s += __shfl_xor(s, 32);
                if (ssq_next && fq == 0) (void)__hip_atomic_fetch_add(ssq_next + row, (ssq_t)(s * SSQ_SCALE), __ATOMIC_RELAXED, __HIP_MEMORY_SCOPE_AGENT); }
            asm volatile("" ::: "memory");
        }
    }
};
struct EpiQKV {
    static constexpr bool PERM = true, AFTER_DRAIN = false;
    bf16_t* qkv; float* F; const ssq_t* ssq; size_t seg_elems;
    __device__ __forceinline__ void operator()(const f32x4 (&acc)[2][2][4][2], const Unit& u, int wr, int wc, int fr, int fq) const {
        const int row0 = u.pm * BM + wr * 64 + fr;
        if (u.pn == 18) {
            if (wc == 0 && fq == 0) {
#pragma unroll
                for (int ai = 0; ai < 2; ++ai)
#pragma unroll
                    for (int m = 0; m < 4; ++m) { const int row = row0 + ai * HALF + m * 16; const float rs = rstd_of(ssq, row);
                        *(PG8_GAS f32x4*)(F + (size_t)row * 8) = acc[ai][0][m][0] * rs; *(PG8_GAS f32x4*)(F + (size_t)row * 8 + 4) = acc[ai][0][m][1] * rs; }
            }
            return;
        }
        const int seg = u.pn >> 1; bf16_t* dst = qkv + (size_t)seg * seg_elems; const float qs = (seg % 3 == 0) ? (0.125f * LOG2E) : 1.0f;
        const int col0 = (u.pn & 1) * BM + wc * 32 + 8 * fq;
        float rsv[2][4];
        rstd8(ssq, row0, qs, rsv);
#pragma unroll
        for (int ai = 0; ai < 2; ++ai)
#pragma unroll
            for (int m = 0; m < 4; ++m) { const int row = row0 + ai * HALF + m * 16; const float rs = rsv[ai][m]; bf16_t* rowp = dst + (size_t)row * 512 + col0;
#pragma unroll
                for (int bj = 0; bj < 2; ++bj) { const f32x4 v0 = acc[ai][bj][m][0] * rs, v1 = acc[ai][bj][m][1] * rs;
                    u32x4 w; w.x = cvt_pk_bf16(v0[0], v0[1]); w.y = cvt_pk_bf16(v0[2], v0[3]); w.z = cvt_pk_bf16(v1[0], v1[1]); w.w = cvt_pk_bf16(v1[2], v1[3]);
                    *(PG8_GAS u32x4*)(rowp + bj * HALF) = w; } }
    }
};
struct EpiGate {
    static constexpr bool PERM = true, AFTER_DRAIN = false;
    bf16_t* qkv; const ssq_t* ssq; size_t seg_elems;
    __device__ __forceinline__ void operator()(const f32x4 (&acc)[2][2][4][2], const Unit& u, int wr, int wc, int fr, int fq) const {
        const int row0 = u.pm * BM + wr * 64 + fr; const int br = u.pn >> 2; bf16_t* dst = qkv + (size_t)(3 * br + 1) * seg_elems;
        const int col0 = (u.pn & 3) * BM + wc * 32 + 8 * fq;
        float rsv[2][4];
        rstd8(ssq, row0, 1.0f, rsv);
#pragma unroll
        for (int ai = 0; ai < 2; ++ai)
#pragma unroll
            for (int m = 0; m < 4; ++m) { const int row = row0 + ai * HALF + m * 16; const float rsn = rsv[ai][m] * -LOG2E; bf16_t* rowp = dst + (size_t)row * 1024 + col0;
#pragma unroll
                for (int bj = 0; bj < 2; ++bj) { float h[8];
#pragma unroll
                    for (int n = 0; n < 2; ++n)
#pragma unroll
                        for (int j = 0; j < 4; ++j) h[4 * n + j] = __builtin_amdgcn_rcpf(1.0f + __builtin_amdgcn_exp2f(acc[ai][bj][m][n][j] * rsn));
                    u32x4 w; w.x = cvt_pk_bf16(h[0], h[1]); w.y = cvt_pk_bf16(h[2], h[3]); w.z = cvt_pk_bf16(h[4], h[5]); w.w = cvt_pk_bf16(h[6], h[7]);
                    *(PG8_GAS u32x4*)(rowp + bj * HALF) = w; } }
    }
};
struct EpiProj {
    static constexpr bool PERM = true, AFTER_DRAIN = false;
    const bf16_t* qkv; bf16_t* mb; size_t seg_elems;
    __device__ __forceinline__ void operator()(const f32x4 (&acc)[2][2][4][2], const Unit& u, int wr, int wc, int fr, int fq) const {
        const int br = u.pn >> 2, pm = u.pm - 384 * br, pn = u.pn & 3;
        const int row0 = pm * BM + wr * 64 + fr, col0 = pn * BM + wc * 32 + 8 * fq; const bf16_t* gate = qkv + (size_t)(3 * br + 1) * seg_elems;
#pragma unroll
        for (int ai = 0; ai < 2; ++ai) {
            u32x4 gpre[4][2], opre[4][2];
#pragma unroll
            for (int m = 0; m < 4; ++m) { const size_t off = (size_t)(row0 + ai * HALF + m * 16) * 1024 + col0;
#pragma unroll
                for (int bj = 0; bj < 2; ++bj) { gpre[m][bj] = *(const PG8_GAS u32x4*)(gate + off + bj * HALF); opre[m][bj] = (u32x4){0u, 0u, 0u, 0u}; if (br) opre[m][bj] = *(const PG8_GAS u32x4*)(mb + off + bj * HALF); } }
#pragma unroll
            for (int m = 0; m < 4; ++m) { const size_t off = (size_t)(row0 + ai * HALF + m * 16) * 1024 + col0;
#pragma unroll
                for (int bj = 0; bj < 2; ++bj) { const u32x4 gw = gpre[m][bj], old = opre[m][bj];
                    const f32x4 a0 = acc[ai][bj][m][0], a1 = acc[ai][bj][m][1]; u32x4 w;
                    w.x = cvt_pk_bf16(bf_lo(old.x) + bf_lo(gw.x) * a0[0], bf_hi(old.x) + bf_hi(gw.x) * a0[1]); w.y = cvt_pk_bf16(bf_lo(old.y) + bf_lo(gw.y) * a0[2], bf_hi(old.y) + bf_hi(gw.y) * a0[3]);
                    w.z = cvt_pk_bf16(bf_lo(old.z) + bf_lo(gw.z) * a1[0], bf_hi(old.z) + bf_hi(gw.z) * a1[1]); w.w = cvt_pk_bf16(bf_lo(old.w) + bf_lo(gw.w) * a1[2], bf_hi(old.w) + bf_hi(gw.w) * a1[3]);
                    *(PG8_GAS u32x4*)(mb + off + bj * HALF) = w; } }
            asm volatile("" ::: "memory");
        }
    }
};
struct ProjOrder {
    int G, c;
    __device__ bool next(int i, Unit& u) const { const int j = i / 3, br = i - 3 * j; const int T = c + G * j; if (T >= 512) return false; u.pm = (T >> 2) + 384 * br; u.pn = (T & 3) + 4 * br; return true; }
    __device__ __forceinline__ void a_ready(const Unit&) const {}
    __device__ __forceinline__ void done(const Unit&) const {}
};
template <class Epi, class Sched, bool ALIGN_EPI = false, bool SP2 = false>
__device__ __forceinline__ void gemm_phase(PG8_LAS unsigned char* lds, const Gemm g, const Sched& S, const Epi& E) {
    int tid_l = threadIdx.x; asm volatile("" : "+v"(tid_l));
    const int tid = tid_l, wid = __builtin_amdgcn_readfirstlane(tid >> 6), lane = tid & 63, wr = wid >> 2, wc = wid & 3, fr = lane & 15, fq = lane >> 4;
    const int K = g.K, nt = K / BK;
    unsigned voffA[2], voffB[2];
#pragma unroll
    for (int i = 0; i < 2; ++i) { int R, C; stage_rc(tid * 16 + i * 8192, R, C); const int Rb = Epi::PERM ? ((R & ~31) + perm32(R & 31)) : R;
        voffA[i] = (unsigned)(R * K + C) * 2u; voffB[i] = (unsigned)(Rb * K + C) * 2u; }
    const size_t kstep = (size_t)(BK * 2);
    const size_t hstep = (size_t)HALF * K * 2;
    const size_t tstep = 2 * hstep;
    const unsigned ldsw = (unsigned)wid * 1024u;
    const int aoff = lds_byte(wr * 64 + fr, fq * 8), boff = lds_byte(wc * 32 + fr, fq * 8);
#define PG8_SA(b, h) (((b) * 2 + (h)) * HTB)
#define PG8_SB(b, h) ((4 + (b) * 2 + (h)) * HTB)
#define PG8_STAGE(bufoff, gbase, voff) do { _Pragma("unroll") for (int _i = 0; _i < 2; ++_i) \
        __builtin_amdgcn_global_load_lds((const unsigned*)((const char*)(gbase) + (voff)[_i]), (PG8_LAS unsigned*)(lds + (bufoff) + ldsw + _i * 8192), 16, 0, 0); } while (0)
#define PG8_LDA(dst, b, h) do { _Pragma("unroll") for (int m = 0; m < 4; ++m) _Pragma("unroll") for (int k = 0; k < 2; ++k) dst[m][k] = *(const PG8_LAS bf16x8*)(lds + PG8_SA(b, h) + aoff + m * 2048 + k * 1024); } while (0)
#define PG8_LDB(dst, b, h) do { _Pragma("unroll") for (int n = 0; n < 2; ++n) _Pragma("unroll") for (int k = 0; k < 2; ++k) dst[n][k] = *(const PG8_LAS bf16x8*)(lds + PG8_SB(b, h) + boff + n * 2048 + k * 1024); } while (0)
#define PG8_MMA(ai, bj, At, Bt) do { __builtin_amdgcn_s_setprio(1); _Pragma("unroll") for (int m = 0; m < 4; ++m) _Pragma("unroll") for (int n = 0; n < 2; ++n) _Pragma("unroll") for (int k = 0; k < 2; ++k) \
        acc[ai][bj][m][n] = __builtin_amdgcn_mfma_f32_16x16x32_bf16(Bt[n][k], At[m][k], acc[ai][bj][m][n], 0, 0, 0); __builtin_amdgcn_s_setprio(0); } while (0)
#define PG8_WAIT_V(n) asm volatile("s_waitcnt vmcnt(" #n ")" ::: "memory")
#define PG8_WAIT_L(n) asm volatile("s_waitcnt lgkmcnt(" #n ")" ::: "memory")
#define PG8_BAR __builtin_amdgcn_s_barrier()
#define PG8_SCHED __builtin_amdgcn_sched_barrier(0)
    Unit cur, nxt; int ui = 0;
    if (!S.next(0, cur)) return;
    f32x4 acc[2][2][4][2];
#pragma unroll
    for (int a = 0; a < 2; ++a)
#pragma unroll
        for (int b = 0; b < 2; ++b)
#pragma unroll
            for (int m = 0; m < 4; ++m)
#pragma unroll
                for (int n = 0; n < 2; ++n) acc[a][b][m][n] = (f32x4){0.f, 0.f, 0.f, 0.f};
    bf16x8 At[4][2], B0[2][2], B1[2][2];
    const char* cA = (const char*)g.A + (size_t)cur.pm * tstep; const char* cB = (const char*)g.Bt + (size_t)cur.pn * tstep;
    S.a_ready(cur);
    if constexpr (SP2) {
        PG8_STAGE(PG8_SB(0, 0), cB, voffB); PG8_STAGE(PG8_SB(0, 1), cB + hstep, voffB); PG8_STAGE(PG8_SA(0, 0), cA, voffA); PG8_STAGE(PG8_SA(0, 1), cA + hstep, voffA);
        if (wr == 1) PG8_BAR;
        PG8_WAIT_V(2); PG8_BAR;
        PG8_STAGE(PG8_SB(1, 0), cB + kstep, voffB); PG8_STAGE(PG8_SA(1, 0), cA + kstep, voffA); PG8_STAGE(PG8_SB(1, 1), cB + hstep + kstep, voffB);
        PG8_WAIT_V(6); PG8_BAR;
    } else {
        PG8_STAGE(PG8_SB(0, 0), cB, voffB); PG8_STAGE(PG8_SA(0, 0), cA, voffA); PG8_STAGE(PG8_SB(0, 1), cB + hstep, voffB); PG8_STAGE(PG8_SA(0, 1), cA + hstep, voffA);
        if (wr == 1) PG8_BAR;
        PG8_WAIT_V(4); PG8_BAR;
        PG8_STAGE(PG8_SB(1, 0), cB + kstep, voffB); PG8_STAGE(PG8_SA(1, 0), cA + kstep, voffA); PG8_STAGE(PG8_SB(1, 1), cB + hstep + kstep, voffB);
        PG8_WAIT_V(6); PG8_BAR;
    }
    for (;;) {
        const bool has_next = S.next(ui + 1, nxt);
        const char* nA = has_next ? (const char*)g.A + (size_t)nxt.pm * tstep : cA; const char* nB = has_next ? (const char*)g.Bt + (size_t)nxt.pn * tstep : cB;
        for (int t = 0; t < nt; t += 2) {
            const bool last = (t == nt - 2);
            const char* a1 = cA + (size_t)(t + 1) * kstep;
            const char* a2 = last ? nA : cA + (size_t)(t + 2) * kstep; const char* b2 = last ? nB : cB + (size_t)(t + 2) * kstep;
            const char* a3 = a2 + kstep; const char* b3 = b2 + kstep;
            if (last && has_next) S.a_ready(nxt);
            if constexpr (SP2) {
            PG8_LDB(B0, 0, 0); PG8_LDB(B1, 0, 1); PG8_SCHED; PG8_LDA(At, 0, 0); PG8_STAGE(PG8_SA(1, 1), a1 + hstep, voffA);
            PG8_WAIT_V(8); PG8_WAIT_L(0); PG8_BAR; PG8_MMA(0, 0, At, B0); PG8_MMA(0, 1, At, B1); PG8_BAR; PG8_SCHED;
            PG8_LDA(At, 0, 1); PG8_STAGE(PG8_SB(0, 0), b2, voffB); PG8_STAGE(PG8_SB(0, 1), b2 + hstep, voffB); PG8_STAGE(PG8_SA(0, 0), a2, voffA);
            PG8_WAIT_V(8); PG8_WAIT_L(0); PG8_BAR; PG8_MMA(1, 0, At, B0); PG8_MMA(1, 1, At, B1); PG8_BAR; PG8_SCHED;
            PG8_LDB(B0, 1, 0); PG8_LDB(B1, 1, 1); PG8_SCHED; PG8_LDA(At, 1, 0); PG8_STAGE(PG8_SA(0, 1), a2 + hstep, voffA);
            PG8_WAIT_V(8); PG8_WAIT_L(0); PG8_BAR; PG8_MMA(0, 0, At, B0); PG8_MMA(0, 1, At, B1); PG8_BAR; PG8_SCHED;
            PG8_LDA(At, 1, 1); PG8_STAGE(PG8_SB(1, 0), b3, voffB); PG8_STAGE(PG8_SB(1, 1), b3 + hstep, voffB); PG8_STAGE(PG8_SA(1, 0), a3, voffA);
            PG8_WAIT_V(8); PG8_WAIT_L(0); PG8_BAR; PG8_MMA(1, 0, At, B0); PG8_MMA(1, 1, At, B1); PG8_BAR; PG8_SCHED;
            } else {
            PG8_LDB(B0, 0, 0); PG8_SCHED; PG8_LDA(At, 0, 0); PG8_STAGE(PG8_SA(1, 1), a1 + hstep, voffA);
            PG8_WAIT_L(8); PG8_BAR; PG8_WAIT_L(0); PG8_MMA(0, 0, At, B0); PG8_BAR; PG8_SCHED;
            PG8_LDB(B1, 0, 1); PG8_STAGE(PG8_SB(0, 0), b2, voffB);
            PG8_BAR; PG8_WAIT_L(0); PG8_MMA(0, 1, At, B1); PG8_BAR;
            PG8_LDA(At, 0, 1); PG8_STAGE(PG8_SA(0, 0), a2, voffA);
            PG8_BAR; PG8_WAIT_L(0); PG8_MMA(1, 0, At, B0); PG8_BAR; PG8_SCHED;
            PG8_STAGE(PG8_SB(0, 1), b2 + hstep, voffB);
            PG8_WAIT_V(6); PG8_BAR; PG8_MMA(1, 1, At, B1); PG8_BAR;
            PG8_LDB(B0, 1, 0); PG8_SCHED; PG8_LDA(At, 1, 0); PG8_STAGE(PG8_SA(0, 1), a2 + hstep, voffA);
            PG8_WAIT_L(8); PG8_BAR; PG8_WAIT_L(0); PG8_MMA(0, 0, At, B0); PG8_BAR; PG8_SCHED;
            PG8_LDB(B1, 1, 1); PG8_STAGE(PG8_SB(1, 0), b3, voffB);
            PG8_BAR; PG8_WAIT_L(0); PG8_MMA(0, 1, At, B1); PG8_BAR;
            PG8_LDA(At, 1, 1); PG8_STAGE(PG8_SA(1, 0), a3, voffA);
            PG8_BAR; PG8_WAIT_L(0); PG8_MMA(1, 0, At, B0); PG8_BAR; PG8_SCHED;
            PG8_STAGE(PG8_SB(1, 1), b3 + hstep, voffB);
            PG8_WAIT_V(6); PG8_BAR; PG8_MMA(1, 1, At, B1); PG8_BAR;
            }
        }
        if constexpr (ALIGN_EPI) { if (wr == 0) PG8_BAR; }
        if constexpr (!Epi::AFTER_DRAIN) { E(acc, cur, wr, wc, fr, fq); S.done(cur); }
        if (!has_next) break;
#pragma unroll
        for (int a = 0; a < 2; ++a)
#pragma unroll
            for (int b = 0; b < 2; ++b)
#pragma unroll
                for (int m = 0; m < 4; ++m)
#pragma unroll
                    for (int n = 0; n < 2; ++n) acc[a][b][m][n] = (f32x4){0.f, 0.f, 0.f, 0.f};
        cur = nxt; cA = nA; cB = nB; ++ui;
        if constexpr (ALIGN_EPI) { if (wr == 1) PG8_BAR; }
    }
    PG8_WAIT_V(0);
    if constexpr (!ALIGN_EPI) { if (wr == 0) PG8_BAR; }
    PG8_BAR;
    if constexpr (Epi::AFTER_DRAIN) { E.fused(acc, cur, wr, wc, fr, fq, lds, wid, lane); S.done(cur); }
#undef PG8_SA
#undef PG8_SB
#undef PG8_STAGE
#undef PG8_LDA
#undef PG8_LDB
#undef PG8_MMA
#undef PG8_WAIT_V
#undef PG8_WAIT_L
#undef PG8_BAR
#undef PG8_SCHED
}
}
#define PG8_SP2 true
#define PG8_ALIGN true
#include <hip/hip_bf16.h>
#include <cmath>
namespace attn_body {
using bf16=__hip_bfloat16;
using bf16x8=__attribute__((ext_vector_type(8)))short;
using s16x4=__attribute__((ext_vector_type(4)))short;
using f32x16=__attribute__((ext_vector_type(16)))float;
using u32x4=__attribute__((ext_vector_type(4)))unsigned;
constexpr int SEQ=2048,D=64,DM=512;
constexpr int NW=8,QBLK=32,QB=QBLK*NW,KVBLK=64,NQB=SEQ/QB;
constexpr int ATTN_PITCH=DM, ATTN_UNIT_ROWS=QB;
__device__ __forceinline__ int crow(int r,int hi){return (r&3)+8*(r>>2)+4*hi;}
#define SBAR() __builtin_amdgcn_sched_barrier(0)
__device__ __forceinline__ void cmask(f32x16&p0,f32x16&p1,int jb,int qrel,int hi){
  const float NEG=-INFINITY; int kb=64*jb+4*hi;
  #pragma unroll
  for(int r=0;r<16;++r){int kv=kb+(r&3)+8*(r>>2); if(kv>qrel)p0[r]=NEG; if(kv+32>qrel)p1[r]=NEG;}
}

constexpr int NSLOT=3, SLOTB=8192;
constexpr int LDS_K=0, LDS_V=NSLOT*SLOTB, LDS_WS=2*NSLOT*SLOTB, LDS_OST=LDS_WS+NW*64*4, LDS_BYTES=LDS_OST+NW*4096;
constexpr float C2=0.125f*1.4426950408889634f;
__device__ __forceinline__ void glds16(const void*gsrc,unsigned lds_dst){unsigned keep;
  asm volatile("s_mov_b32 %0, m0\n\ts_mov_b32 m0, %2\n\ts_nop 0\n\tglobal_load_lds_dwordx4 %1, off\n\ts_mov_b32 m0, %0":"=&s"(keep):"v"(gsrc),"s"(lds_dst):"memory");}
__device__ __forceinline__ float max3f(float a,float b,float c){float r;asm("v_max3_f32 %0, %1, %2, %3":"=v"(r):"v"(a),"v"(b),"v"(c));return r;}
__device__ __forceinline__ float max2f(float a,float b){float r;asm("v_max_f32_e32 %0, %1, %2":"=v"(r):"v"(a),"v"(b));return r;}
__device__ __forceinline__ float fadd_s(float a,float b){float r;asm("v_add_f32_e32 %0, %1, %2":"=v"(r):"v"(a),"v"(b));return r;}
__device__ __forceinline__ float fsub_s(float a,float b){float r;asm("v_sub_f32_e32 %0, %1, %2":"=v"(r):"v"(a),"v"(b));return r;}
typedef float f32x2_t __attribute__((ext_vector_type(2))); typedef __bf16 bf16x2_t __attribute__((ext_vector_type(2)));
__device__ __forceinline__ unsigned cvtpk_s(float lo,float hi){f32x2_t v={lo,hi};bf16x2_t b=__builtin_convertvector(v,bf16x2_t);return __builtin_bit_cast(unsigned,b);}
#define WAIT_BAR(N) asm volatile("s_waitcnt vmcnt(" #N ") lgkmcnt(0)\n\ts_barrier":::"memory")

__device__ __forceinline__ void qkt(f32x16&p0,f32x16&p1,const char*Kslot,const bf16x8*qr,const f32x16&negm,int r32,int hi){
  const char*kb=Kslot+hi*1024+r32*16;
  #pragma unroll
  for(int d0=0;d0<4;++d0){
    const bf16x8 b0=*reinterpret_cast<const bf16x8*>(kb+d0*2048);
    const bf16x8 b1=*reinterpret_cast<const bf16x8*>(kb+d0*2048+512);
    if(d0==0){p0=__builtin_amdgcn_mfma_f32_32x32x16_bf16(b0,qr[0],negm,0,0,0);p1=__builtin_amdgcn_mfma_f32_32x32x16_bf16(b1,qr[0],negm,0,0,0);}
    else{p0=__builtin_amdgcn_mfma_f32_32x32x16_bf16(b0,qr[d0],p0,0,0,0);p1=__builtin_amdgcn_mfma_f32_32x32x16_bf16(b1,qr[d0],p1,0,0,0);}}
}
typedef __attribute__((address_space(3))) const char* lds_cptr;
typedef short v4i16_t __attribute__((ext_vector_type(4)));
__device__ __forceinline__ void kload8(bf16x8*kf,lds_cptr kp){
  kf[0]=*(const __attribute__((address_space(3))) bf16x8*)(kp);      kf[1]=*(const __attribute__((address_space(3))) bf16x8*)(kp+512);
  kf[2]=*(const __attribute__((address_space(3))) bf16x8*)(kp+2048); kf[3]=*(const __attribute__((address_space(3))) bf16x8*)(kp+2560);
  kf[4]=*(const __attribute__((address_space(3))) bf16x8*)(kp+4096); kf[5]=*(const __attribute__((address_space(3))) bf16x8*)(kp+4608);
  kf[6]=*(const __attribute__((address_space(3))) bf16x8*)(kp+6144); kf[7]=*(const __attribute__((address_space(3))) bf16x8*)(kp+6656);
}
__device__ __forceinline__ void kload2(bf16x8*kf,lds_cptr kp,int j){ kf[2*j]=*(const __attribute__((address_space(3))) bf16x8*)(kp+j*2048); kf[2*j+1]=*(const __attribute__((address_space(3))) bf16x8*)(kp+j*2048+512); }
__device__ __forceinline__ s16x4 vtr(lds_cptr p){ return __builtin_bit_cast(s16x4,__builtin_amdgcn_ds_read_tr16_b64_v4i16((__attribute__((address_space(3))) v4i16_t*)p)); }
__device__ __forceinline__ float rowmax(const f32x16&p0,const f32x16&p1){
  float a=max3f(p0[0],p0[1],p1[0]),b=max3f(p0[2],p0[3],p1[1]);a=max3f(a,p1[2],p1[3]);
  #pragma unroll
  for(int r=4;r<16;r+=4){a=max3f(a,p0[r],p0[r+1]);b=max3f(b,p0[r+2],p0[r+3]);a=max3f(a,p1[r],p1[r+1]);b=max3f(b,p1[r+2],p1[r+3]);}
  const float m=max2f(a,b);
  auto rr=__builtin_amdgcn_permlane32_swap(__float_as_uint(m),__float_as_uint(m),false,false);
  return max2f(__uint_as_float(rr[0]),__uint_as_float(rr[1]));
}
__device__ __forceinline__ void pv(f32x16*o,int vb,bf16x8 pa0,bf16x8 pa1,bf16x8 pa2,bf16x8 pa3){
  #pragma unroll
  for(int d0=0;d0<2;++d0){s16x4 lo[4],hi[4];
    #pragma unroll
    for(int ks=0;ks<4;++ks){
      asm volatile("ds_read_b64_tr_b16 %0,%1 offset:%c2":"=&v"(lo[ks]):"v"(vb),"i"(d0*4096+ks*1024):"memory");
      asm volatile("ds_read_b64_tr_b16 %0,%1 offset:%c2":"=&v"(hi[ks]):"v"(vb),"i"(d0*4096+ks*1024+512):"memory");}
    asm volatile("s_waitcnt lgkmcnt(0)":::"memory");SBAR();
    #define PK(k) (bf16x8){lo[k][0],lo[k][1],lo[k][2],lo[k][3],hi[k][0],hi[k][1],hi[k][2],hi[k][3]}
    o[d0]=__builtin_amdgcn_mfma_f32_32x32x16_bf16(pa0,PK(0),o[d0],0,0,0);
    o[d0]=__builtin_amdgcn_mfma_f32_32x32x16_bf16(pa1,PK(1),o[d0],0,0,0);
    o[d0]=__builtin_amdgcn_mfma_f32_32x32x16_bf16(pa2,PK(2),o[d0],0,0,0);
    o[d0]=__builtin_amdgcn_mfma_f32_32x32x16_bf16(pa3,PK(3),o[d0],0,0,0);
    #undef PK
  }
}

#ifndef ATTN_STORE16
#define ATTN_STORE16(p,v) (*(__attribute__((address_space(1))) u32x4*)(p)=(v))
#endif
typedef __attribute__((address_space(3))) const float* lds_fptr;
typedef float f32x4a __attribute__((ext_vector_type(4)));
typedef __attribute__((address_space(3))) const f32x4a* lds_f4ptr;
constexpr int LDS_TAB=LDS_BYTES;
constexpr int LDS_ATT_TOTAL=LDS_TAB+SEQ*4;
__device__ __forceinline__ void qkt2(f32x16&p0,f32x16&p1,lds_cptr Kslot,const bf16x8*qr,int r32,int hi){
  const lds_cptr kb=Kslot+hi*1024+r32*16;
  #pragma unroll
  for(int d0=0;d0<4;++d0){
    const bf16x8 b0=*(const __attribute__((address_space(3))) bf16x8*)(kb+d0*2048);
    const bf16x8 b1=*(const __attribute__((address_space(3))) bf16x8*)(kb+d0*2048+512);
    p0=__builtin_amdgcn_mfma_f32_32x32x16_bf16(b0,qr[d0],p0,0,0,0);p1=__builtin_amdgcn_mfma_f32_32x32x16_bf16(b1,qr[d0],p1,0,0,0);}
}
template<int THRL,int MODE> __device__ __forceinline__ void attn_unit(int qb,int t0,const bf16*Qh,const bf16*__restrict__ Kh,const bf16*__restrict__ Vh,bf16*Oh,float sl2,const float*gtab,char*shm){
  int tid_l=threadIdx.x; asm volatile("":"+v"(tid_l)); const int tid=tid_l,lane=tid&63,r32=lane&31,hi=lane>>5; const int wid=__builtin_amdgcn_readfirstlane(tid>>6);
  const int q0=qb*QB;
  const bf16*Qw=Qh+(long)(q0+wid*QBLK)*DM;
  const unsigned lds0=(unsigned)(uintptr_t)shm;
  float*wsf=(float*)(shm+LDS_WS)+wid*64;
  const bf16*ksrc=Kh+(long)(t0*KVBLK+lane)*DM+wid*8;
  const bf16*vsrc=Vh+(long)(t0*KVBLK+16*(wid&3)+(lane>>2))*DM+(wid>>2)*32+(lane&3)*8;
  const unsigned kdst=lds0+LDS_K+wid*1024, vdst=lds0+LDS_V+wid*1024;
  #define DMA_K(t,slot) glds16(ksrc+(long)(t)*KVBLK*DM,(unsigned)__builtin_amdgcn_readfirstlane(kdst+(slot)))
  #define DMA_V(t,slot) glds16(vsrc+(long)(t)*KVBLK*DM,(unsigned)__builtin_amdgcn_readfirstlane(vdst+(slot)))
  const int vb0=(int)(lds0+LDS_V)+((lane>>4)&1)*32+(lane&3)*8+(4*hi+((lane&15)>>2))*64;
  bf16x8 kf[8];
  const lds_cptr shm3=(lds_cptr)shm; const lds_cptr kp0=shm3+LDS_K+hi*1024+r32*16; const lds_cptr vp0=shm3+LDS_V+((lane>>4)&1)*32+(lane&3)*8+(4*hi+((lane&15)>>2))*64;
  const lds_fptr tab3=(lds_fptr)(shm3+LDS_TAB)+64*t0;
  const int NT=(q0+QB)/KVBLK-t0;
  DMA_K(0,0);DMA_V(0,0);DMA_K(1,SLOTB);
  if constexpr(MODE==1){
    __attribute__((address_space(3))) float*tw=(__attribute__((address_space(3))) float*)((__attribute__((address_space(3))) char*)shm+LDS_TAB);
    for(int i=tid;i<q0+QB;i+=NW*64)tw[i]=gtab[i];
  }
  bf16x8 qr[4];
  #pragma unroll
  for(int d0=0;d0<4;++d0)qr[d0]=*reinterpret_cast<const bf16x8*>(&Qw[(long)r32*DM+d0*16+hi*8]);
  float mhat=0.f,l_reg=0.f;f32x16 o[2];o[0]=f32x16{};o[1]=f32x16{};
  const int qrel=wid*QBLK+r32;
  #define CMASK(P0,P1,t) do{int jb_=(t)-(NT-4); if(jb_>=0)cmask(P0,P1,jb_,qrel,hi);}while(0)
  #define CINIT(C0,C1,t) do{ if constexpr(MODE==0){ const float base_=__builtin_fmaf(sl2,(float)(64*(t)+4*hi),-mhat); \
      _Pragma("unroll") for(int r=0;r<16;++r){ C0[r]=__builtin_fmaf(sl2,(float)((r&3)+8*(r>>2)),base_); C1[r]=__builtin_fmaf(sl2,(float)((r&3)+8*(r>>2)+32),base_);} } \
    else { const lds_f4ptr tb_=(lds_f4ptr)(tab3+64*(t)+4*hi); \
      _Pragma("unroll") for(int g=0;g<4;++g){ const f32x4a a_=tb_[2*g], b_=tb_[2*g+8]; \
        _Pragma("unroll") for(int j=0;j<4;++j){ C0[4*g+j]=a_[j]-mhat; C1[4*g+j]=b_[j]-mhat; } } } }while(0)
  bool resc=false;
  #define START(P0,P1) do{ const float rm=rowmax(P0,P1); resc=false; \
    { const float dl=max2f(rm,0.f); mhat=fadd_s(mhat,dl); \
      _Pragma("unroll") for(int r=0;r<16;++r){P0[r]=fsub_s(P0[r],dl);P1[r]=fsub_s(P1[r],dl);} } \
    _Pragma("unroll") for(int r=0;r<16;++r)P0[r]=__builtin_amdgcn_exp2f(P0[r]); }while(0)
  #define RESC() do{ if(resc){ asm volatile("s_waitcnt lgkmcnt(0)":::"memory"); \
      _Pragma("unroll") for(int d_=0;d_<2;++d_) _Pragma("unroll") for(int r=0;r<16;++r)o[d_][r]*=wsf[crow(r,hi)]; } }while(0)
  f32x16 pA0,pA1,pB0,pB1;
  int sl_prev=0,sl_cur=0,sl_next=SLOTB;
  #define ROT() do{sl_prev=sl_cur;sl_cur=sl_next;sl_next=(sl_next==(NSLOT-1)*SLOTB)?0:sl_next+SLOTB;}while(0)
  DMA_K(2,2*SLOTB);
  WAIT_BAR(3);
  if constexpr(MODE==0) mhat=sl2*(float)(q0+qrel-64*t0); else mhat=tab3[q0+qrel-64*t0];
  CINIT(pA0,pA1,0);
  qkt2(pA0,pA1,shm3+LDS_K,qr,r32,hi);asm volatile("s_nop 15\n\ts_nop 7":"+v"(pA0),"+v"(pA1));CMASK(pA0,pA1,0);
  START(pA0,pA1);
  _Pragma("unroll") for(int r=0;r<16;++r)pA1[r]=__builtin_amdgcn_exp2f(pA1[r]);
  WAIT_BAR(0);
  DMA_K(3,0);DMA_V(1,SLOTB);
  ROT();
  kload8(kf,kp0+sl_cur);
  WAIT_BAR(2);
  s16x4 vlo[8],vhi[8]; u32x4 pw0,pw1,pw2,pw3;
  #define PKW(P,B) cvtpk_s(P[B],P[B+1])
  #define PAF(k) __builtin_bit_cast(bf16x8,pw##k)
  #define VFR(i) (bf16x8){vlo[i][0],vlo[i][1],vlo[i][2],vlo[i][3],vhi[i][0],vhi[i][1],vhi[i][2],vhi[i][3]}
  #define PIN(x) asm volatile("":"+v"(x))
  #define MX3(a,b,c) __builtin_fmaxf(__builtin_fmaxf((a),(b)),(c))
  #define GAPA(MF,A0,A1,A2,A3,W0,W1,PW) do{ MF; sacc+=A0; sacc+=A1; sacc+=A2; sacc+=A3; PIN(sacc); W0; W1; PIN(PW); SBAR(); }while(0)
  #define EX(v) __builtin_amdgcn_exp2f(v)
  #define GAPB(MF,X,B) do{ MF; X[B]=EX(X[B]); X[B+1]=EX(X[B+1]); X[B+2]=EX(X[B+2]); X[B+3]=EX(X[B+3]); PIN(X); SBAR(); }while(0)
  #define VRD(i) do{ vlo[i]=vtr(vp_+(((i)>>2)*4096+((i)&3)*1024)); vhi[i]=vtr(vp_+(((i)>>2)*4096+((i)&3)*1024+512)); }while(0)
  #define KRD(G,j) do{ if(G){ kload2(kf,kp0+sl_next,j); SBAR(); } }while(0)
  #define STEP(C0,C1,P0,P1,t,GK,GV,GL) do{ CINIT(C0,C1,t); SBAR(); \
    const lds_cptr vp_=vp0+sl_prev; \
    VRD(0); SBAR(); float sacc=(P0[0]+P0[1]); \
    GAPA(C0=__builtin_amdgcn_mfma_f32_32x32x16_bf16(kf[0],qr[0],C0,0,0,0), P0[2],P0[3],P0[4],P0[5],     pw0[0]=PKW(P0,0), pw0[1]=PKW(P0,2), pw0); \
    VRD(4); SBAR(); GAPA(C1=__builtin_amdgcn_mfma_f32_32x32x16_bf16(kf[1],qr[0],C1,0,0,0), P0[6],P0[7],P0[8],P0[9],     pw0[2]=PKW(P0,4), pw0[3]=PKW(P0,6), pw0); \
    VRD(1); SBAR(); GAPA(C0=__builtin_amdgcn_mfma_f32_32x32x16_bf16(kf[2],qr[1],C0,0,0,0),   P0[10],P0[11],P0[12],P0[13], pw1[0]=PKW(P0,8), pw1[1]=PKW(P0,10), pw1); \
    VRD(5); SBAR(); GAPA(C1=__builtin_amdgcn_mfma_f32_32x32x16_bf16(kf[3],qr[1],C1,0,0,0),   P0[14],P0[15],P1[0],P1[1],   pw1[2]=PKW(P0,12),pw1[3]=PKW(P0,14), pw1); \
    VRD(2); SBAR(); GAPA(C0=__builtin_amdgcn_mfma_f32_32x32x16_bf16(kf[4],qr[2],C0,0,0,0),   P1[2],P1[3],P1[4],P1[5],     pw2[0]=PKW(P1,0), pw2[1]=PKW(P1,2), pw2); \
    VRD(6); SBAR(); GAPA(C1=__builtin_amdgcn_mfma_f32_32x32x16_bf16(kf[5],qr[2],C1,0,0,0),   P1[6],P1[7],P1[8],P1[9],     pw2[2]=PKW(P1,4), pw2[3]=PKW(P1,6), pw2); \
    VRD(3); SBAR(); GAPA(C0=__builtin_amdgcn_mfma_f32_32x32x16_bf16(kf[6],qr[3],C0,0,0,0),   P1[10],P1[11],P1[12],P1[13], pw3[0]=PKW(P1,8), pw3[1]=PKW(P1,10), pw3); \
    VRD(7); SBAR(); GAPA(C1=__builtin_amdgcn_mfma_f32_32x32x16_bf16(kf[7],qr[3],C1,0,0,0),   P1[14],P1[15],0.f,0.f,       pw3[2]=PKW(P1,12),pw3[3]=PKW(P1,14), pw3); \
    l_reg+=sacc; \
    if(GK){DMA_K((t)+3,sl_cur);} if(GV){DMA_V((t)+1,sl_next);} \
    CMASK(C0,C1,t); \
    { float a=MX3(C0[0],C0[1],C1[0]),b=MX3(C0[2],C0[3],C1[1]); a=MX3(a,C1[2],C1[3]); \
      _Pragma("unroll") for(int r=4;r<16;r+=4){a=MX3(a,C0[r],C0[r+1]);b=MX3(b,C0[r+2],C0[r+3]);a=MX3(a,C1[r],C1[r+1]);b=MX3(b,C1[r+2],C1[r+3]);} \
      float rm=__builtin_fmaxf(a,b); { auto rr=__builtin_amdgcn_permlane32_swap(__float_as_uint(rm),__float_as_uint(rm),false,false); rm=__builtin_fmaxf(__uint_as_float(rr[0]),__uint_as_float(rr[1])); } \
      resc=false; \
      if(__builtin_expect(__any(rm>(float)THRL),0)){ const float dl=__builtin_fmaxf(rm,0.f); mhat+=dl; \
        _Pragma("unroll") for(int r=0;r<16;++r){C0[r]-=dl;C1[r]-=dl;} \
        const float f=__builtin_amdgcn_exp2f(-dl); l_reg*=f; if(hi==0)wsf[r32]=f; resc=true; } } \
    SBAR(); \
    GAPB(o[0]=__builtin_amdgcn_mfma_f32_32x32x16_bf16(PAF(0),VFR(0),o[0],0,0,0), C0,0); \
    GAPB(o[1]=__builtin_amdgcn_mfma_f32_32x32x16_bf16(PAF(0),VFR(4),o[1],0,0,0), C0,4); \
    KRD(GL,0); GAPB(o[0]=__builtin_amdgcn_mfma_f32_32x32x16_bf16(PAF(1),VFR(1),o[0],0,0,0), C0,8); \
    KRD(GL,1); GAPB(o[1]=__builtin_amdgcn_mfma_f32_32x32x16_bf16(PAF(1),VFR(5),o[1],0,0,0), C0,12); \
    KRD(GL,2); GAPB(o[0]=__builtin_amdgcn_mfma_f32_32x32x16_bf16(PAF(2),VFR(2),o[0],0,0,0), C1,0); \
    KRD(GL,3); GAPB(o[1]=__builtin_amdgcn_mfma_f32_32x32x16_bf16(PAF(2),VFR(6),o[1],0,0,0), C1,4); \
    GAPB(o[0]=__builtin_amdgcn_mfma_f32_32x32x16_bf16(PAF(3),VFR(3),o[0],0,0,0), C1,8); \
    GAPB(o[1]=__builtin_amdgcn_mfma_f32_32x32x16_bf16(PAF(3),VFR(7),o[1],0,0,0), C1,12); \
    }while(0)
  int t=1;
  #undef CMASK
  #define CMASK(P0,P1,t) do{}while(0)
  for(;t+5<NT;t+=2){
    STEP(pB0,pB1,pA0,pA1,t,true,true,true);     WAIT_BAR(2); RESC(); ROT();
    STEP(pA0,pA1,pB0,pB1,t+1,true,true,true);   WAIT_BAR(2); RESC(); ROT();
  }
  #undef CMASK
  #define CMASK(P0,P1,t) do{int jb_=(t)-(NT-4); if(jb_>=0)cmask(P0,P1,jb_,qrel,hi);}while(0)
  #define ENDW(tt) do{ if((tt)+3<NT){WAIT_BAR(2);} else if((tt)+2<NT){WAIT_BAR(1);} else {WAIT_BAR(0);} }while(0)
  for(;t+1<NT;t+=2){
    STEP(pB0,pB1,pA0,pA1,t,(t+3<NT),(t+1<NT),(t+1<NT));       ENDW(t);   RESC(); ROT();
    STEP(pA0,pA1,pB0,pB1,t+1,(t+4<NT),(t+2<NT),(t+2<NT));     ENDW(t+1); RESC(); ROT();
  }
  STEP(pB0,pB1,pA0,pA1,NT-1,false,false,false); RESC();
  { float sacc=pB0[0]+pB0[1]; _Pragma("unroll") for(int r=2;r<16;++r)sacc+=pB0[r]; _Pragma("unroll") for(int r=0;r<16;++r)sacc+=pB1[r]; l_reg+=sacc;
    pw0=(u32x4){PKW(pB0,0),PKW(pB0,2),PKW(pB0,4),PKW(pB0,6)};pw1=(u32x4){PKW(pB0,8),PKW(pB0,10),PKW(pB0,12),PKW(pB0,14)};pw2=(u32x4){PKW(pB1,0),PKW(pB1,2),PKW(pB1,4),PKW(pB1,6)};pw3=(u32x4){PKW(pB1,8),PKW(pB1,10),PKW(pB1,12),PKW(pB1,14)};
    SBAR(); pv(o,vb0+sl_cur,PAF(0),PAF(1),PAF(2),PAF(3)); }
  #undef GAPA
  #undef GAPB
  #undef EX
  #undef VRD
  #undef KRD
  #undef STEP
  #undef ENDW
  #undef MX3
  #undef PIN
  #undef VFR
  {auto rr=__builtin_amdgcn_permlane32_swap(__float_as_uint(l_reg),__float_as_uint(l_reg),false,false);l_reg=__uint_as_float(rr[0])+__uint_as_float(rr[1]);}
  if(hi==0)wsf[32+r32]=l_reg;asm volatile("s_waitcnt lgkmcnt(0)":::"memory");
  float rli[16];
  #pragma unroll
  for(int r=0;r<16;++r)rli[r]=__builtin_amdgcn_rcpf(wsf[32+crow(r,hi)]);
  bf16*Ow=Oh+(long)(q0+wid*QBLK)*DM;
  { bf16*stg=(bf16*)(shm+LDS_OST)+wid*2048;
    #pragma unroll
    for(int r=0;r<16;++r){const int orow=crow(r,hi);
      #pragma unroll
      for(int d0=0;d0<2;++d0)((unsigned short*)stg)[orow*64+d0*32+r32]=(unsigned short)cvtpk_s(o[d0][r]*rli[r],0.f);}
    asm volatile("s_waitcnt lgkmcnt(0)":::"memory");
    #pragma unroll
    for(int i=0;i<4;++i){const int row=i*8+(lane>>3),ch=lane&7; const u32x4 v=*(const u32x4*)(stg+row*64+ch*8); ATTN_STORE16(Ow+(long)row*DM+ch*8,v);} }
  asm volatile("s_waitcnt lgkmcnt(0)\n\ts_barrier":::"memory");
  #undef CMASK
  #undef CINIT
  #undef START
  #undef RESC
  #undef ROT
}

__device__ __forceinline__ void sb_unit(int qb,const bf16*Qh,const bf16*__restrict__ Kh,const bf16*__restrict__ Vh,bf16*Oh,char*shm){
  int tid_l=threadIdx.x; asm volatile("":"+v"(tid_l)); const int tid=tid_l,lane=tid&63,r32=lane&31,hi=lane>>5; const int wid=__builtin_amdgcn_readfirstlane(tid>>6);
  const int q0=qb*QB;
  const bf16*Qw=Qh+(long)(q0+wid*QBLK)*DM;
  const unsigned lds0=(unsigned)(uintptr_t)shm;
  const bf16*ksrc=Kh+(long)lane*DM+wid*8;
  const bf16*vsrc=Vh+(long)(16*(wid&3)+(lane>>2))*DM+(wid>>2)*32+(lane&3)*8;
  const unsigned kdst=lds0+LDS_K+wid*1024, vdst=lds0+LDS_V+wid*1024;
  const int vb0=(int)(lds0+LDS_V)+((lane>>4)&1)*32+(lane&3)*8+(4*hi+((lane&15)>>2))*64;
  typedef __attribute__((address_space(3))) int* lds_iptr;
  const lds_iptr flg=(lds_iptr)((__attribute__((address_space(3))) char*)shm+LDS_WS);
  const int NT=(q0+QB)/KVBLK;
  DMA_K(NT-1,0);DMA_V(NT-1,0);
  bf16x8 qr[4];
  #pragma unroll
  for(int d0=0;d0<4;++d0)qr[d0]=*reinterpret_cast<const bf16x8*>(&Qw[(long)r32*DM+d0*16+hi*8]);
  f32x16 o[2];o[0]=f32x16{};o[1]=f32x16{};
  const int qw0=q0+wid*QBLK, qrow=qw0+r32;
  float carry=1.f; bool done=false; int cur=0;
  for(int t=NT-1;t>=0;--t){
    const int nxt=cur^SLOTB;
    if(t>0){DMA_K(t-1,nxt);DMA_V(t-1,nxt);WAIT_BAR(2);} else {WAIT_BAR(0);}
    const bool active=(64*t<=qw0+30)&&!done;
    if(active){
      f32x16 p0=f32x16{},p1=f32x16{};
      qkt2(p0,p1,(lds_cptr)shm+LDS_K+cur,qr,r32,hi);
      const bool diag=(64*t+63>=qw0);
      float kp[32];
      #pragma unroll
      for(int r=0;r<16;++r){
        #pragma unroll
        for(int p=0;p<2;++p){
          const float z=p?p1[r]:p0[r];
          const float e=__builtin_amdgcn_exp2f(-__builtin_fabsf(z));
          const float ri=__builtin_amdgcn_rcpf(1.0f+e), er=e*ri;
          float bt=(z>=0.f)?ri:er, kv_=(z>=0.f)?er:ri;
          if(diag){ const int kv=64*t+32*p+(r&3)+8*(r>>2)+4*hi; if(kv>=qrow){bt=0.f;kv_=1.f;} }
          kp[16*p+r]=kv_; if(p)p1[r]=bt; else p0[r]=bt;
        }
      }
      float G[8],Go[8];
      #pragma unroll
      for(int u=0;u<8;++u){ const int b=16*(u>>2)+4*(u&3); G[u]=(kp[b]*kp[b+1])*(kp[b+2]*kp[b+3]);
        auto rr=__builtin_amdgcn_permlane32_swap(__float_as_uint(G[u]),__float_as_uint(G[u]),false,false); Go[u]=__uint_as_float(hi?rr[0]:rr[1]); }
      float A=1.f;
      #pragma unroll
      for(int u=7;u>=0;--u){ const int p=u>>2,g=u&3; float run=(carry*A)*(hi?1.f:Go[u]);
        #pragma unroll
        for(int j=3;j>=0;--j){ const int r=4*g+j; const float bt=p?p1[r]:p0[r]; const float w=bt*run; if(p)p1[r]=w; else p0[r]=w; run*=kp[16*p+r]; }
        A*=G[u]*Go[u]; }
      carry*=A;
      u32x4 pw0,pw1,pw2,pw3;
      #define PKW(P,B) cvtpk_s(P[B],P[B+1])
      pw0=(u32x4){PKW(p0,0),PKW(p0,2),PKW(p0,4),PKW(p0,6)};pw1=(u32x4){PKW(p0,8),PKW(p0,10),PKW(p0,12),PKW(p0,14)};pw2=(u32x4){PKW(p1,0),PKW(p1,2),PKW(p1,4),PKW(p1,6)};pw3=(u32x4){PKW(p1,8),PKW(p1,10),PKW(p1,12),PKW(p1,14)};
      SBAR(); pv(o,vb0+cur,PAF(0),PAF(1),PAF(2),PAF(3));
      done=__all(carry<1.17549435e-38f);
    }
    if(lane==0)flg[wid]=done?1:0;
    if(t>0){WAIT_BAR(2);} else {WAIT_BAR(0);}
    const int alld=flg[0]&flg[1]&flg[2]&flg[3]&flg[4]&flg[5]&flg[6]&flg[7];
    cur=nxt;
    if(alld)break;
  }
  asm volatile("s_waitcnt vmcnt(0)":::"memory");
  bf16*Ow=Oh+(long)(q0+wid*QBLK)*DM;
  { bf16*stg=(bf16*)(shm+LDS_OST)+wid*2048;
    #pragma unroll
    for(int r=0;r<16;++r){const int orow=crow(r,hi);
      #pragma unroll
      for(int d0=0;d0<2;++d0)((unsigned short*)stg)[orow*64+d0*32+r32]=(unsigned short)cvtpk_s(o[d0][r],0.f);}
    asm volatile("s_waitcnt lgkmcnt(0)":::"memory");
    #pragma unroll
    for(int i=0;i<4;++i){const int row=i*8+(lane>>3),ch=lane&7; const u32x4 v=*(const u32x4*)(stg+row*64+ch*8); ATTN_STORE16(Ow+(long)row*DM+ch*8,v);} }
  asm volatile("s_waitcnt lgkmcnt(0)\n\ts_barrier":::"memory");
  #undef PKW
  #undef PAF
  #undef DMA_K
  #undef DMA_V
}
#undef SBAR
#undef WAIT_BAR
}
#ifndef EN_P0
#define EN_P0 1
#endif
#ifndef EN_P1
#define EN_P1 1
#endif
#ifndef EN_P2
#define EN_P2 1
#endif
#ifndef EN_P3
#define EN_P3 1
#endif
#ifndef EN_P4
#define EN_P4 1
#endif
#ifndef EN_P5
#define EN_P5 1
#endif
#ifndef EN_P6
#define EN_P6 1
#endif
#ifndef EN_P7
#define EN_P7 1
#endif
#ifndef EN_P8
#define EN_P8 1
#endif
#ifndef EN_P9
#define EN_P9 1
#endif
#ifndef EN_P10
#define EN_P10 1
#endif
#ifndef EN_PF
#define EN_PF 1
#endif
#include <hip/hip_cooperative_groups.h>
namespace cg = cooperative_groups;
constexpr int NWAVES = 8;
constexpr int M = 32768, DMOD = 1024, DFF = 2816, SEQL = 2048, NBATCH = 16, NIN = 7688;
constexpr size_t MiB = 1u << 20;
constexpr size_t WS_CTL = 0, CTL_ZERO_BYTES = 2 * MiB;
constexpr size_t WS_SSQ = 474 * MiB, SSQ_BYTES = (size_t)6 * 32768 * 8;
constexpr size_t WS_NRM = 1 * MiB + 768 * 1024;
constexpr size_t WS_F = 2 * MiB, WS_C2 = 3 * MiB;
constexpr size_t WS_W = 4 * MiB;
constexpr size_t W_13A = 0, W_2A = 11 * MiB, W_IN = W_2A + 5 * MiB + 512 * 1024, W_G = 26 * MiB, W_PROJ = 32 * MiB, W_OUT = 35 * MiB, W_13B = 37 * MiB, W_2B = 48 * MiB;
constexpr size_t WS_HB = 58 * MiB, WS_MB = 122 * MiB, WS_QKV = 186 * MiB, SEG_BYTES = 32 * MiB, WS_END = 476 * MiB;
constexpr size_t SEG_ELEMS = SEG_BYTES / 2;
static_assert(W_IN == 16 * MiB + 512 * 1024 && W_IN + (size_t)4864 * 1024 * 2 == W_G && W_2B + (size_t)1024 * 2816 * 2 <= 54 * MiB, "weight map");
constexpr int NWIN = 4864;
constexpr int RING_BYTES = 131072, MISC_OFF = RING_BYTES, LDS_BYTES = 147456;
static_assert(attn_body::LDS_ATT_TOTAL <= RING_BYTES, "attention scratch fits the ring region");

#ifndef REP_FFN
#define REP_FFN 1
#endif
#ifndef REP_MIX
#define REP_MIX 1
#endif
#ifndef REP_SYNC
#define REP_SYNC 0
#endif
#ifndef REP_ATT
#define REP_ATT 0
#endif
#ifndef REP_P0
#define REP_P0 1
#endif
#define RUN_GEMM(REP, EPI, ORD) do { for (int rp_ = 0; rp_ < (REP); ++rp_) { if (rp_) GSYNC(); pg8::gemm_phase<EPI, ORD, PG8_ALIGN, PG8_SP2>(ldsl, g, S, E); } } while (0)
#define RUN_GEMM_RES(REP) do { for (int rp_ = 0; rp_ < (REP); ++rp_) { pg8::EpiRes E2_ = E; if (rp_ + 1 < (REP)) { E2_.alpha = 0.f; E2_.ssq_next = nullptr; } pg8::gemm_phase<pg8::EpiRes, pg8::StaticOrder, PG8_ALIGN, PG8_SP2>(ldsl, g, S, E2_); if (rp_ + 1 < (REP)) GSYNC(); } } while (0)
#define GAS __attribute__((address_space(1)))
#define LAS __attribute__((address_space(3)))
typedef unsigned short bf16;
typedef unsigned v4u __attribute__((ext_vector_type(4)));
typedef float f32x4 __attribute__((ext_vector_type(4)));
#define LDS_WAIT() asm volatile("s_waitcnt lgkmcnt(0)" ::: "memory")
__device__ __forceinline__ unsigned f2bf(float f) { unsigned u = __builtin_bit_cast(unsigned, f); return (u + 0x7fffu + ((u >> 16) & 1u)) >> 16; }
typedef float fr_f32x2_t __attribute__((ext_vector_type(2))); typedef __bf16 fr_bf16x2_t __attribute__((ext_vector_type(2)));
__device__ __forceinline__ unsigned pk2(float lo, float hi) { const fr_f32x2_t v = {lo, hi}; const fr_bf16x2_t b = __builtin_convertvector(v, fr_bf16x2_t); return __builtin_bit_cast(unsigned, b); }
__device__ __forceinline__ float wave_sum(float v) {
#pragma unroll
    for (int o = 1; o < 64; o <<= 1) v += __shfl_xor(v, o);
    return v;
}
__device__ __forceinline__ void tr_item(const float* W, int Nsrc, int K, int k0, int n0src, int nvalid, bf16* WTrow0, const float* g, LAS float* scr, int lane) {
    const int nl = lane & 31;
#pragma unroll 8
    for (int i = 0; i < 32; ++i) { const int kk = 2 * i + (lane >> 5); float v = 0.f; if (nl < nvalid) { v = ((const GAS float*)W)[(size_t)(k0 + kk) * Nsrc + n0src + nl]; if (g) v *= ((const GAS float*)g)[k0 + kk]; } scr[kk * 33 + nl] = v; }
    LDS_WAIT(); asm volatile("" ::: "memory");
    const int c = lane & 7;
#pragma unroll
    for (int j = 0; j < 4; ++j) { const int n = (lane >> 3) + 8 * j; const LAS float* s = scr + (8 * c) * 33 + n;
        v4u o; o.x = pk2(s[0 * 33], s[1 * 33]); o.y = pk2(s[2 * 33], s[3 * 33]); o.z = pk2(s[4 * 33], s[5 * 33]); o.w = pk2(s[6 * 33], s[7 * 33]);
        *(GAS v4u*)(WTrow0 + (size_t)n * K + k0 + 8 * c) = o; }
    LDS_WAIT(); asm volatile("" ::: "memory");
}

#define XB_TMO      128
#define XB_XCNT(j)  (256  + 64 * (j))
#define XB_XSUB(j)  (1280 + 64 * (j))
#define XB_XGEN(j)  (2304 + 64 * (j))
#define XB_TOP      3328
#define XB_TOPGEN   3392
#define XCD_BAR_WORDS 3456
#define XB_SPIN_CAP (1u << 18)

__device__ __forceinline__ unsigned xb_ld(unsigned* p)              { return __hip_atomic_load(p, __ATOMIC_RELAXED, __HIP_MEMORY_SCOPE_AGENT); }
__device__ __forceinline__ unsigned xb_add(unsigned* p, unsigned v) { return __hip_atomic_fetch_add(p, v, __ATOMIC_RELAXED, __HIP_MEMORY_SCOPE_AGENT); }
__device__ __forceinline__ unsigned xb_xcc_id() { return (unsigned)__builtin_amdgcn_s_getreg((3 << 11) | 20) & 0xFu; }
#define XB_SPIN(cond, bar) do { unsigned _sp = 0; while (cond) { __builtin_amdgcn_s_sleep(1); \
    if ((++_sp & 255u) == 0u) { if (xb_ld(&(bar)[XB_TMO])) break; if (_sp > XB_SPIN_CAP) { atomicAdd(&(bar)[XB_TMO], 1u); break; } } } } while (0)

struct XcdBarrier {
    unsigned* bar; unsigned x;
    volatile LAS unsigned* st;
};

__device__ __forceinline__ XcdBarrier xcd_barrier_post(unsigned* bar, volatile LAS unsigned* st) {
    XcdBarrier b; b.bar = bar; b.x = xb_xcc_id(); b.st = st;
    if (threadIdx.x == 0) (void)xb_add(&bar[XB_XCNT(b.x)], 1u);
    return b;
}
__device__ __forceinline__ void xcd_barrier_complete(unsigned* bar, unsigned x, unsigned& nloc, unsigned& nx) {
    const unsigned G = gridDim.x * gridDim.y * gridDim.z;
    unsigned sum, cnt, mine, sp = 0u;
    for (;;) {
        sum = 0u; cnt = 0u; mine = 0u;
#pragma unroll
        for (unsigned j = 0; j < 16; ++j) { const unsigned c = xb_ld(&bar[XB_XCNT(j)]); sum += c; cnt += (c > 0u) ? 1u : 0u; mine = (j == x) ? c : mine; }
        if (sum == G) break;
        __builtin_amdgcn_s_sleep(1);
        if ((++sp & 255u) == 0u) { if (xb_ld(&bar[XB_TMO])) break; if (sp > XB_SPIN_CAP) { atomicAdd(&bar[XB_TMO], 1u); break; } }
    }
    nloc = mine > 0u ? mine : 1u; nx = cnt > 0u ? cnt : 1u;
}

__device__ __forceinline__ void xcd_barrier(const XcdBarrier& b) {
    asm volatile("s_waitcnt vmcnt(0)" ::: "memory");
    __syncthreads();
    if (threadIdx.x == 0) {
        unsigned* bar = b.bar;
        __builtin_amdgcn_s_waitcnt(0);
        unsigned nloc = b.st[0], nx = b.st[1];
        if (nloc == 0u) { xcd_barrier_complete(bar, b.x, nloc, nx); b.st[0] = nloc; b.st[1] = nx; }
        const unsigned old = xb_add(&bar[XB_XSUB(b.x)], 1u);
        const unsigned gen = old / nloc;
        if (old + 1u == (gen + 1u) * nloc) {
            __builtin_amdgcn_fence(__ATOMIC_RELEASE, "agent");
            asm volatile("s_waitcnt vmcnt(0)" ::: "memory");
            const unsigned og = xb_add(&bar[XB_TOP], 1u);
            const unsigned tg = og / nx;
            if (og + 1u == (tg + 1u) * nx) xb_add(&bar[XB_TOPGEN], 1u);
            else XB_SPIN(xb_ld(&bar[XB_TOPGEN]) == tg, bar);
            __builtin_amdgcn_fence(__ATOMIC_ACQUIRE, "agent");
            xb_add(&bar[XB_XGEN(b.x)], 1u);
            asm volatile("s_waitcnt vmcnt(0)" ::: "memory");
        } else {
            XB_SPIN(xb_ld(&bar[XB_XGEN(b.x)]) == gen, bar);
            __builtin_amdgcn_fence(__ATOMIC_ACQUIRE, "agent");
            asm volatile("s_waitcnt vmcnt(0)" ::: "memory");
        }
    }
    __syncthreads();
}

constexpr int CW_BAR = 4096;
struct Args { const float* in[22]; float* out; unsigned char* ws; };

__global__ void __launch_bounds__(NWAVES * 64, 2) mk_fwd(Args args) {
    extern __shared__ __attribute__((aligned(16))) unsigned char lds[];
    cg::grid_group grid = cg::this_grid();
    { LAS unsigned* mz = (LAS unsigned*)((LAS unsigned char*)lds + MISC_OFF); if (threadIdx.x < 64) mz[threadIdx.x] = 0u; __syncthreads(); }
    XcdBarrier bar = xcd_barrier_post((unsigned*)(args.ws + WS_CTL) + CW_BAR, (volatile LAS unsigned*)((LAS unsigned char*)lds + MISC_OFF) + 8);
#define GSYNC() do { if (__builtin_expect(args.ws == nullptr, 0)) grid.sync(); else xcd_barrier(bar); } while (0)
#define ENV \
    int tid_e = threadIdx.x; asm volatile("" : "+v"(tid_e)); const int tid = tid_e, lane = tid & 63, wave = __builtin_amdgcn_readfirstlane(tid >> 6); (void)lane; \
    int G = gridDim.x, bx = blockIdx.x; asm volatile("" : "+s"(G), "+s"(bx)); const int gw = bx * NWAVES + wave, NGW = G * NWAVES; (void)gw; (void)NGW; \
    unsigned char* ws = args.ws; asm volatile("" : "+s"(ws)); int l = l_it; asm volatile("" : "+s"(l)); \
    LAS unsigned char* ldsl = (LAS unsigned char*)lds; (void)ldsl; LAS float* scr = (LAS float*)(ldsl + wave * 16384); (void)scr; \
    volatile LAS int* MISC = (volatile LAS int*)(ldsl + MISC_OFF); (void)MISC; unsigned* ctl = (unsigned*)(ws + WS_CTL); (void)ctl; \
    pg8::ssq_t* ssqb = (pg8::ssq_t*)(ws + WS_SSQ); float* Fb = (float*)(ws + WS_F); float* C2b = (float*)(ws + WS_C2); bf16* Wb = (bf16*)(ws + WS_W); \
    bf16* HB = (bf16*)(ws + WS_HB); bf16* MB = (bf16*)(ws + WS_MB); bf16* QKV = (bf16*)(ws + WS_QKV); bf16* HFF = QKV; \
    const float* x = args.in[0]; float* out = args.out; \
    pg8::ssq_t* ssq0 = ssqb + (size_t)(3 * l) * M; pg8::ssq_t* ssq1 = ssq0 + M; pg8::ssq_t* ssq2 = ssq1 + M; pg8::ssq_t* ssq3 = (l == 0) ? (ssq2 + M) : nullptr; \
    (void)Fb; (void)C2b; (void)Wb; (void)HB; (void)MB; (void)HFF; (void)x; (void)out; (void)ssq0; (void)ssq1; (void)ssq2; (void)ssq3;
#pragma nounroll
    for (int l_it = 0; l_it < 2; ++l_it) {
#if EN_P0
        for (int rp0_ = 0; rp0_ < REP_P0; ++rp0_) {
            ENV
            const float* n1 = args.in[1] + l * 1024; const float* w1a = args.in[2] + (size_t)l * 1024 * DFF; const float* w3a = args.in[3] + (size_t)l * 1024 * DFF; const float* w2a = args.in[4] + (size_t)l * DFF * 1024;
            const float* nm = args.in[5] + l * 1024; const float* win = args.in[6] + (size_t)l * 1024 * NIN;
            const float* pa = args.in[13] + (size_t)l * 512 * 1024; const float* pb = args.in[14] + (size_t)l * 512 * 1024; const float* pc = args.in[15] + (size_t)l * 512 * 1024;
            const float* wo = args.in[16] + (size_t)l * 1024 * 1024; const float* n2 = args.in[17] + l * 1024;
            const float* w1b = args.in[18] + (size_t)l * 1024 * DFF; const float* w3b = args.in[19] + (size_t)l * 1024 * DFF; const float* w2b = args.in[20] + (size_t)l * DFF * 1024;
            constexpr int I13 = 16 * 176, I2 = 44 * 32, IIN = 16 * 152, IG = 16 * 96, IP = 8 * 32, IO = 16 * 32;
            constexpr int NITEMS = 2 * I13 + 2 * I2 + IIN + IG + 3 * IP + IO;
            for (int it = gw; it < NITEMS; it += NGW) {
                int r = it;
                if (r < 2 * I13) { const bool second = r >= I13; if (second) r -= I13; const int kb = r / 176, j = r % 176, tile = j >> 3, sub = j & 7;
                    const float* src = second ? (sub < 4 ? w1b : w3b) : (sub < 4 ? w1a : w3a);
                    tr_item(src, DFF, 1024, 64 * kb, 128 * tile + 32 * (sub & 3), 32, (bf16*)((unsigned char*)Wb + (second ? W_13B : W_13A)) + (size_t)(32 * j) * 1024, second ? n2 : n1, scr, lane); continue; }
                r -= 2 * I13;
                if (r < 2 * I2) { const bool second = r >= I2; if (second) r -= I2; const int kb = r / 32, j = r % 32;
                    tr_item(second ? w2b : w2a, 1024, DFF, 64 * kb, 32 * j, 32, (bf16*)((unsigned char*)Wb + (second ? W_2B : W_2A)) + (size_t)(32 * j) * DFF, nullptr, scr, lane); continue; }
                r -= 2 * I2;
                if (r < IIN) { const int kb = r / 152, j = r % 152, row0 = 32 * j; int src0, nv;
                    if (row0 < 3072) { src0 = row0; nv = 32; } else if (row0 < 4608) { src0 = row0 + 8; nv = 32; } else if (row0 == 4608) { src0 = 3072; nv = 8; } else { src0 = 0; nv = 0; }
                    tr_item(win, NIN, 1024, 64 * kb, src0, nv, (bf16*)((unsigned char*)Wb + W_IN) + (size_t)row0 * 1024, nm, scr, lane); continue; }
                r -= IIN;
                if (r < IG) { const int kb = r / 96, j = r % 96;
                    tr_item(win, NIN, 1024, 64 * kb, 4616 + 32 * j, 32, (bf16*)((unsigned char*)Wb + W_G) + (size_t)(32 * j) * 1024, nm, scr, lane); continue; }
                r -= IG;
                if (r < 3 * IP) { const int br = r / IP; r -= br * IP; const int kb = r / 32, j = r % 32; const float* src = br == 0 ? pa : (br == 1 ? pb : pc);
                    tr_item(src, 1024, 512, 64 * kb, 32 * j, 32, (bf16*)((unsigned char*)Wb + W_PROJ) + (size_t)(br * 1024 + 32 * j) * 512, nullptr, scr, lane); continue; }
                r -= 3 * IP;
                { const int kb = r / 32, j = r % 32;
                    tr_item(wo, 1024, 1024, 64 * kb, 32 * j, 32, (bf16*)((unsigned char*)Wb + W_OUT) + (size_t)(32 * j) * 1024, nullptr, scr, lane); }
            }
            if (l == 0) {
                for (int m = gw; m < M; m += NGW) {
                    const GAS f32x4* xr = (const GAS f32x4*)(x + (size_t)m * 1024) + lane; f32x4 v[4]; float s = 0.f;
#pragma unroll
                    for (int j = 0; j < 4; ++j) { v[j] = xr[64 * j]; s += (v[j].x * v[j].x + v[j].y * v[j].y) + (v[j].z * v[j].z + v[j].w * v[j].w); }
                    s = wave_sum(s);
                    GAS unsigned long long* o8 = (GAS unsigned long long*)(HB + (size_t)m * 1024) + lane;
#pragma unroll
                    for (int j = 0; j < 4; ++j) o8[64 * j] = (unsigned long long)pk2(v[j].x, v[j].y) | ((unsigned long long)pk2(v[j].z, v[j].w) << 32);
                    if (lane == 0) ssqb[m] = (pg8::ssq_t)(s * pg8::SSQ_SCALE);
                }
            }
        }
#endif
        GSYNC();
#if EN_P1
        { ENV
        { pg8::Gemm g{HB, (const bf16*)((unsigned char*)Wb + W_13A), M, 2 * DFF, 1024}; pg8::StaticOrder S; S.init(M, 2 * DFF, G, bx);
          pg8::EpiSwiGLU E{HFF, DFF, ssq0}; RUN_GEMM(REP_FFN, pg8::EpiSwiGLU, pg8::StaticOrder); }
        }
#endif
        GSYNC();
#if EN_P2
        { ENV
        { pg8::Gemm g{HFF, (const bf16*)((unsigned char*)Wb + W_2A), M, 1024, DFF}; pg8::StaticOrder S; S.init(M, 1024, G, bx);
          pg8::EpiRes E{HB, ssq1, 0.5f}; RUN_GEMM_RES(REP_FFN); }
        }
#endif
        GSYNC();
#if EN_P3
        { ENV
        { pg8::Gemm g{HB, (const bf16*)((unsigned char*)Wb + W_IN), M, NWIN, 1024}; pg8::StaticOrder S; S.init(M, NWIN, G, bx);
          pg8::EpiQKV E{QKV, Fb, ssq1, SEG_ELEMS}; RUN_GEMM(REP_MIX, pg8::EpiQKV, pg8::StaticOrder); }
        }
#endif
        GSYNC();
#if EN_P4
        { ENV
        if (gw < NBATCH * 8) {
            const int b = gw >> 3, h = gw & 7; const float fb = args.in[7][l * 8 + h];
            float v[32]; float run = 0.f;
#pragma unroll
            for (int i = 0; i < 32; ++i) { const float xx = ((const GAS float*)Fb)[((size_t)b * SEQL + lane * 32 + i) * 8 + h] + fb;
                const float e = __builtin_amdgcn_exp2f(-__builtin_fabsf(xx) * pg8::LOG2E); const float ls2 = __builtin_fminf(xx, 0.f) * pg8::LOG2E - __builtin_amdgcn_logf(1.0f + e);
                run += ls2; v[i] = run; }
            float inc = run;
#pragma unroll
            for (int d = 1; d < 64; d <<= 1) { const float t = __shfl_up(inc, d); if (lane >= d) inc += t; }
            const float pre = inc - run;
            float* dst = C2b + ((size_t)b * 8 + h) * SEQL + lane * 32;
#pragma unroll
            for (int i = 0; i < 32; ++i) dst[i] = -(pre + v[i]);
        }
        { float* NRM = (float*)(ws + WS_NRM);
          for (int it = gw; it < 16384; it += NGW) { const int sg = it >> 12, rem = it & 4095, b = rem >> 8, hd = (rem >> 5) & 7, tl = rem & 31;
            if (sg < 2 && hd >= 2) continue;
            const int qseg = (sg == 0) ? 0 : (sg == 1) ? 1 : (sg == 2) ? 3 : 4;
            const GAS v4u* src = (const GAS v4u*)(QKV + (size_t)qseg * SEG_ELEMS + ((size_t)b * SEQL + tl * 64 + lane) * 512 + hd * 64); float ss = 0.f;
#pragma unroll
            for (int j = 0; j < 8; ++j) { const v4u w = src[j]; const float a0 = pg8::bf_lo(w.x), a1 = pg8::bf_hi(w.x), a2 = pg8::bf_lo(w.y), a3 = pg8::bf_hi(w.y), a4 = pg8::bf_lo(w.z), a5 = pg8::bf_hi(w.z), a6 = pg8::bf_lo(w.w), a7 = pg8::bf_hi(w.w);
                ss += (a0 * a0 + a1 * a1) + (a2 * a2 + a3 * a3) + ((a4 * a4 + a5 * a5) + (a6 * a6 + a7 * a7)); }
#pragma unroll
            for (int o = 1; o < 64; o <<= 1) ss = __builtin_fmaxf(ss, __shfl_xor(ss, o));
            if (lane == 0) NRM[it] = ss; } }
        }
#endif
        GSYNC();
#if EN_P5
        {
            ENV
            using abf = attn_body::bf16;
            for (;;) {
                if (tid == 0) MISC[0] = (int)atomicAdd(ctl + l, 1u);
                __syncthreads(); const int it = MISC[0]; __syncthreads();
                if (it >= 4096) break;
                if (it < 3072) { const int qb = 7 - it / 384, rem = it % 384, b = rem / 24, vh = rem % 24; const size_t rb = (size_t)b * SEQL * 512;
                    const float* NRM = (const float*)(ws + WS_NRM); int t0 = 0;
                    if (vh < 4 || vh >= 16) { const int sq = (vh < 16) ? 0 : 2, hd = (vh < 16) ? ((vh >> 1) & 1) : (vh - 16); const int tt = lane & 31;
                        const float* nq = NRM + (((size_t)sq * 16 + b) * 8 + hd) * 32 + 4 * qb; const float* nk = NRM + (((size_t)(sq + 1) * 16 + b) * 8 + hd) * 32;
                        const float qn2 = __builtin_fmaxf(__builtin_fmaxf(nq[0], nq[1]), __builtin_fmaxf(nq[2], nq[3])); const float kn2 = nk[tt];
                        float bd; if (vh < 16) bd = 0.25f * pg8::LOG2E * (float)(64 * tt + 63 - 256 * qb); else { const float* ct = C2b + ((size_t)b * 8 + (vh - 16)) * SEQL; bd = ct[64 * tt + 63] - ct[256 * qb]; }
                        const bool keep = (tt >= 4 * qb) || !(sqrtf(qn2 * kn2) + bd < -150.f);
                        const unsigned long long km = __ballot(keep); t0 = __builtin_amdgcn_readfirstlane((int)__builtin_ctzll(km)) & ~1; }
                    if (vh < 16) { const int h = vh >> 2, c = (vh >> 1) & 1, e = vh & 1; const float sl2 = __builtin_amdgcn_exp2f(-2.0f * (float)(h + 1)) * pg8::LOG2E;
                        attn_body::attn_unit<8, 0>(qb, t0, (const abf*)(QKV + 0 * SEG_ELEMS + rb + h * 128 + c * 64), (const abf*)(QKV + 1 * SEG_ELEMS + rb + h * 128 + c * 64), (const abf*)(QKV + 2 * SEG_ELEMS + rb + h * 128 + e * 64),
                                                   (abf*)(MB + (size_t)c * SEG_ELEMS + rb + h * 128 + e * 64), sl2, nullptr, (char*)lds);
                    } else { const int h = vh - 16;
                        attn_body::attn_unit<8, 1>(qb, t0, (const abf*)(QKV + 3 * SEG_ELEMS + rb + h * 64), (const abf*)(QKV + 4 * SEG_ELEMS + rb + h * 64), (const abf*)(QKV + 5 * SEG_ELEMS + rb + h * 64),
                                                   (abf*)(QKV + 3 * SEG_ELEMS + rb + h * 64), 0.f, C2b + ((size_t)b * 8 + h) * SEQL, (char*)lds); }
                } else { const int i2 = it - 3072, qb = 7 - i2 / 128, rem = i2 % 128, b = rem >> 3, h = rem & 7; const size_t rb = (size_t)b * SEQL * 512;
                    attn_body::sb_unit(qb, (const abf*)(QKV + 6 * SEG_ELEMS + rb + h * 64), (const abf*)(QKV + 7 * SEG_ELEMS + rb + h * 64), (const abf*)(QKV + 8 * SEG_ELEMS + rb + h * 64), (abf*)(QKV + 6 * SEG_ELEMS + rb + h * 64), (char*)lds); }
            }
        }
#endif
        GSYNC();
#if EN_P6
        for (int rs_ = 0; rs_ < REP_SYNC; ++rs_) GSYNC();
#if REP_ATT
        { ENV
            using abf = attn_body::bf16;
            for (;;) {
                if (tid == 0) MISC[0] = (int)atomicAdd(ctl + 8 + l, 1u);
                __syncthreads(); const int it = MISC[0]; __syncthreads();
                if (it >= 2048) break;
                const int qb = 7 - it / 256, rem = it % 256, b = rem / 16, vh = rem % 16; const size_t rb = (size_t)b * SEQL * 512;
                const int h = vh >> 2, c = (vh >> 1) & 1, e = vh & 1; const float sl2 = __builtin_amdgcn_exp2f(-2.0f * (float)(h + 1)) * pg8::LOG2E;
                attn_body::attn_unit<8, 0>(qb, 0, (const abf*)(QKV + 0 * SEG_ELEMS + rb + h * 128 + c * 64), (const abf*)(QKV + 1 * SEG_ELEMS + rb + h * 128 + c * 64), (const abf*)(QKV + 2 * SEG_ELEMS + rb + h * 128 + e * 64),
                                           (abf*)(MB + (size_t)c * SEG_ELEMS + rb + h * 128 + e * 64), sl2, nullptr, (char*)lds);
            }
        }
        GSYNC();
#endif
        { ENV
        { pg8::Gemm g{HB, (const bf16*)((unsigned char*)Wb + W_G), M, 3072, 1024}; pg8::StaticOrder S; S.init(M, 3072, G, bx);
          pg8::EpiGate E{QKV, ssq1, SEG_ELEMS}; RUN_GEMM(REP_MIX, pg8::EpiGate, pg8::StaticOrder); }
        {
            const float lam_init = (l == 0) ? 0.2f : (0.8f - 0.6f * 0.7408182206817179f);
            const float s1 = wave_sum(args.in[8][l * 64 + lane] * args.in[9][l * 64 + lane]), s2 = wave_sum(args.in[10][l * 64 + lane] * args.in[11][l * 64 + lane]);
            const float lam = __expf(s1) - __expf(s2) + lam_init;
            const float* sg = args.in[12] + l * 128 + (lane & 15) * 8; float gs[8];
#pragma unroll
            for (int i = 0; i < 8; ++i) gs[i] = sg[i] * (1.0f - lam_init);
            for (int m = gw; m < M; m += NGW) {
                const v4u a = *(const GAS v4u*)(MB + (size_t)m * 512 + lane * 8), bq = *(const GAS v4u*)(MB + SEG_ELEMS + (size_t)m * 512 + lane * 8);
                float v[8];
                v[0] = pg8::bf_lo(a.x) - lam * pg8::bf_lo(bq.x); v[1] = pg8::bf_hi(a.x) - lam * pg8::bf_hi(bq.x); v[2] = pg8::bf_lo(a.y) - lam * pg8::bf_lo(bq.y); v[3] = pg8::bf_hi(a.y) - lam * pg8::bf_hi(bq.y);
                v[4] = pg8::bf_lo(a.z) - lam * pg8::bf_lo(bq.z); v[5] = pg8::bf_hi(a.z) - lam * pg8::bf_hi(bq.z); v[6] = pg8::bf_lo(a.w) - lam * pg8::bf_lo(bq.w); v[7] = pg8::bf_hi(a.w) - lam * pg8::bf_hi(bq.w);
                float s = 0.f;
#pragma unroll
                for (int i = 0; i < 8; ++i) s += v[i] * v[i];
                s += __shfl_xor(s, 1); s += __shfl_xor(s, 2); s += __shfl_xor(s, 4); s += __shfl_xor(s, 8);
                const float rs = 1.0f / sqrtf(s * (1.0f / 128.0f) + 1e-5f);
                v4u o; o.x = pk2(v[0] * rs * gs[0], v[1] * rs * gs[1]); o.y = pk2(v[2] * rs * gs[2], v[3] * rs * gs[3]); o.z = pk2(v[4] * rs * gs[4], v[5] * rs * gs[5]); o.w = pk2(v[6] * rs * gs[6], v[7] * rs * gs[7]);
                *(GAS v4u*)(QKV + (size_t)m * 512 + lane * 8) = o;
            }
        }
        }
#endif
        GSYNC();
#if EN_P7
        { ENV
        { pg8::Gemm g{QKV, (const bf16*)((unsigned char*)Wb + W_PROJ), M, 1024, 512}; pg8::ProjOrder S{G, bx};
          pg8::EpiProj E{QKV, MB, SEG_ELEMS}; RUN_GEMM(REP_MIX, pg8::EpiProj, pg8::ProjOrder); }
        }
#endif
        GSYNC();
#if EN_P8
        { ENV
        { pg8::Gemm g{MB, (const bf16*)((unsigned char*)Wb + W_OUT), M, 1024, 1024}; pg8::StaticOrder S; S.init(M, 1024, G, bx);
          pg8::EpiRes E{HB, ssq2, 1.0f}; RUN_GEMM_RES(REP_MIX); }
        }
#endif
        GSYNC();
#if EN_P9
        { ENV
        { pg8::Gemm g{HB, (const bf16*)((unsigned char*)Wb + W_13B), M, 2 * DFF, 1024}; pg8::StaticOrder S; S.init(M, 2 * DFF, G, bx);
          pg8::EpiSwiGLU E{HFF, DFF, ssq2}; RUN_GEMM(REP_FFN, pg8::EpiSwiGLU, pg8::StaticOrder); }
        }
#endif
        GSYNC();
#if EN_P10
        { ENV
        { pg8::Gemm g{HFF, (const bf16*)((unsigned char*)Wb + W_2B), M, 1024, DFF}; pg8::StaticOrder S; S.init(M, 1024, G, bx);
          pg8::EpiRes E{HB, ssq3, 0.5f}; RUN_GEMM_RES(REP_FFN); }
        }
#endif
        GSYNC();
    }
#if EN_PF
    {
        const int l_it = 0; ENV
        const GAS f32x4* gn = (const GAS f32x4*)args.in[21]; const f32x4 g0 = gn[2 * lane], g1 = gn[2 * lane + 1], g2 = gn[128 + 2 * lane], g3 = gn[129 + 2 * lane];
        for (int m0 = gw; m0 < M; m0 += 2 * NGW) {
            v4u ra[2], rb[2];
#pragma unroll
            for (int q = 0; q < 2; ++q) { const GAS v4u* hr = (const GAS v4u*)(HB + (size_t)(m0 + q * NGW) * 1024); ra[q] = hr[lane]; rb[q] = hr[64 + lane]; }
#pragma unroll
            for (int q = 0; q < 2; ++q) { const v4u a = ra[q], bq = rb[q]; const int m = m0 + q * NGW;
                const f32x4 v0 = {pg8::bf_lo(a.x), pg8::bf_hi(a.x), pg8::bf_lo(a.y), pg8::bf_hi(a.y)}, v1 = {pg8::bf_lo(a.z), pg8::bf_hi(a.z), pg8::bf_lo(a.w), pg8::bf_hi(a.w)};
                const f32x4 v2 = {pg8::bf_lo(bq.x), pg8::bf_hi(bq.x), pg8::bf_lo(bq.y), pg8::bf_hi(bq.y)}, v3 = {pg8::bf_lo(bq.z), pg8::bf_hi(bq.z), pg8::bf_lo(bq.w), pg8::bf_hi(bq.w)};
                float s = ((v0.x * v0.x + v0.y * v0.y) + (v0.z * v0.z + v0.w * v0.w)) + ((v1.x * v1.x + v1.y * v1.y) + (v1.z * v1.z + v1.w * v1.w));
                s += ((v2.x * v2.x + v2.y * v2.y) + (v2.z * v2.z + v2.w * v2.w)) + ((v3.x * v3.x + v3.y * v3.y) + (v3.z * v3.z + v3.w * v3.w));
                const float rs = 1.0f / sqrtf(wave_sum(s) * (1.0f / 1024.0f) + 1e-6f);
                GAS f32x4* o = (GAS f32x4*)(out + (size_t)m * 1024);
                o[2 * lane] = v0 * rs * g0; o[2 * lane + 1] = v1 * rs * g1; o[128 + 2 * lane] = v2 * rs * g2; o[129 + 2 * lane] = v3 * rs * g3; }
        }
    }
#endif
}

extern "C" void kernel_launch(void* const* d_in, const int* in_sizes, int n_in, void* d_out, int out_size, void* d_ws, size_t ws_size, hipStream_t stream) {
    static int grid = 0;
    if (grid == 0) {
        if (n_in != 22 || in_sizes[0] != M * DMOD || out_size != M * DMOD || ws_size < WS_END) { fprintf(stderr, "kernel_launch: unexpected shapes (n_in %d, ws %zu)\n", n_in, ws_size); grid = -1; return; }
        int dev = 0, cus = 0, per_cu = 0;
        if (hipGetDevice(&dev) != hipSuccess || hipDeviceGetAttribute(&cus, hipDeviceAttributeMultiprocessorCount, dev) != hipSuccess) { grid = -1; return; }
        if (hipFuncSetAttribute((const void*)mk_fwd, hipFuncAttributeMaxDynamicSharedMemorySize, LDS_BYTES) != hipSuccess) { fprintf(stderr, "kernel_launch: hipFuncSetAttribute failed\n"); grid = -1; return; }
        if (hipOccupancyMaxActiveBlocksPerMultiprocessor(&per_cu, (const void*)mk_fwd, NWAVES * 64, LDS_BYTES) != hipSuccess || per_cu < 1) { fprintf(stderr, "kernel_launch: occupancy query says %d\n", per_cu); per_cu = 1; }
        (void)hipGetLastError();
        grid = cus * 1;
        fprintf(stderr, "kernel_launch: grid %d (occupancy query %d per CU)\n", grid, per_cu);
    }
    if (grid < 0) return;
    (void)hipMemsetAsync((char*)d_ws + WS_CTL, 0, CTL_ZERO_BYTES, stream);
    (void)hipMemsetAsync((char*)d_ws + WS_SSQ, 0, SSQ_BYTES, stream);
    Args a{};
    for (int i = 0; i < 22; ++i) a.in[i] = (const float*)d_in[i];
    a.out = (float*)d_out; a.ws = (unsigned char*)d_ws;
    void* kargs[] = {&a};
    hipError_t e = hipLaunchCooperativeKernel((const void*)mk_fwd, dim3(grid), dim3(NWAVES * 64), kargs, LDS_BYTES, stream);
    if (e != hipSuccess) fprintf(stderr, "kernel_launch: cooperative launch failed: %s\n", hipGetErrorString(e));
}
```
